# Optimizing an MI355X kernel written in HIP

```python
import math
import jax, jax.numpy as jnp
from jax import lax
import numpy as np

D_MODEL = 2048
BATCH = 16
SEQ = 2048
DEPTH = 2

MIX_WIDTH = D_MODEL
HEAD_DIM = 128
ATT_WIDTH = MIX_WIDTH // 2
ATT_HEADS = ATT_WIDTH // HEAD_DIM
DILATED_PATTERN = ((128, 1), (512, 4), (2048, 16))
CONV_CHANNELS = MIX_WIDTH - ATT_WIDTH
CONV_K = 3
IN_WIDTH = 3 * ATT_WIDTH + 3 * CONV_CHANNELS
D_FF = 256 * ((8 * D_MODEL // 3 + 255) // 256)
S5_GROUP = 16
S5_STATE = 64
S5_GROUPS = D_MODEL // S5_GROUP
ROPE_THETA = 10000.0
RMS_EPS = 1e-6
NEG_INF = -1e30
N_AB = (DEPTH + 1) // 2
N_C = DEPTH // 2

kernel_name = 'hybrid_dilated_attn_shortconv_s5_macaron'


def rmsnorm(x, g):
    xf = x.astype(jnp.float32)
    y = xf * lax.rsqrt(jnp.mean(xf * xf, axis=-1, keepdims=True) + RMS_EPS)
    return (y * g.astype(jnp.float32)).astype(x.dtype)


def swiglu(x, w1, w3, w2):
    return (jax.nn.silu(x @ w1) * (x @ w3)) @ w2


def rope_tables(seq):
    half = HEAD_DIM // 2
    inv = ROPE_THETA ** (-jnp.arange(0, half, dtype=jnp.float32) * 2.0 / HEAD_DIM)
    ang = jnp.arange(seq, dtype=jnp.float32)[:, None] * inv[None, :]
    return jnp.cos(ang), jnp.sin(ang)


def apply_rope(t, cos, sin):
    half = HEAD_DIM // 2
    tf = t.astype(jnp.float32)
    t1, t2 = tf[..., :half], tf[..., half:]
    c, s = cos[:, None, :], sin[:, None, :]
    return jnp.concatenate([t1 * c - t2 * s, t2 * c + t1 * s], axis=-1)


def dilated_branch(q, k, v, window, dilation):
    bsz, seq, nh, dh = q.shape
    L = window // dilation
    n = seq // dilation
    nb = -(-n // L)
    pad = nb * L - n

    def to_blocks(t):
        t = t.reshape(bsz, n, dilation, nh, dh).transpose(0, 2, 1, 3, 4)
        t = jnp.pad(t, ((0, 0), (0, 0), (0, pad), (0, 0), (0, 0)))
        return t.reshape(bsz, dilation, nb, L, nh, dh)

    def with_prev(t):
        prev = jnp.pad(t, ((0, 0), (0, 0), (1, 0), (0, 0), (0, 0), (0, 0)))[:, :, :-1]
        return jnp.concatenate([prev, t], axis=3)

    qb = to_blocks(q)
    kw = with_prev(to_blocks(k))
    vw = with_prev(to_blocks(v))
    s = jnp.einsum('bgnqhd,bgnkhd->bghnqk', qb, kw)
    qi = jnp.arange(L)[:, None]
    kj = jnp.arange(2 * L)[None, :]
    dist = qi + L - kj
    band = (dist >= 0) & (dist <= L)
    kpos = jnp.arange(nb)[:, None, None] * L + kj[None] - L
    valid = band[None] & (kpos >= 0)
    s = jnp.where(valid, s, NEG_INF)
    m = jnp.max(s, axis=-1, keepdims=True)
    p = jnp.exp(s - m)
    denom = jnp.sum(p, axis=-1)
    o = jnp.einsum('bghnqk,bgnkhd->bgnqhd', p, vw)
    denom_t = denom.transpose(0, 1, 3, 4, 2)
    o = o / denom_t[..., None]
    lse = m[..., 0].transpose(0, 1, 3, 4, 2) + jnp.log(denom_t)

    def from_blocks(t):
        t = t.reshape((bsz, dilation, nb * L) + t.shape[4:])[:, :, :n]
        t = jnp.moveaxis(t, 1, 2)
        return t.reshape((bsz, seq) + t.shape[3:])

    return from_blocks(o), from_blocks(lse)


def mixer_attn_conv(h, w_in, conv_w, w_out, cos, sin):
    bsz, seq, _ = h.shape
    proj = h @ w_in
    a = ATT_WIDTH
    c = CONV_CHANNELS
    q, k, v, gate_b, gate_c, x_in = jnp.split(
        proj, [a, 2 * a, 3 * a, 3 * a + c, 3 * a + 2 * c], axis=-1)
    q = apply_rope(q.reshape(bsz, seq, ATT_HEADS, HEAD_DIM), cos, sin) * (HEAD_DIM ** -0.5)
    k = apply_rope(k.reshape(bsz, seq, ATT_HEADS, HEAD_DIM), cos, sin)
    v = v.reshape(bsz, seq, ATT_HEADS, HEAD_DIM).astype(jnp.float32)
    outs, lses = [], []
    for window, dilation in DILATED_PATTERN:
        o_i, l_i = dilated_branch(q, k, v, window, dilation)
        outs.append(o_i)
        lses.append(l_i)
    wts = jax.nn.softmax(jnp.stack(lses, axis=0), axis=0)
    att = jnp.einsum('nbsh,nbshd->bshd', wts, jnp.stack(outs, axis=0))
    att = att.reshape(bsz, seq, ATT_WIDTH).astype(h.dtype)
    u = gate_c * x_in
    conv = lax.conv_general_dilated(
        u, conv_w[:, None, :], window_strides=(1,), padding=[(CONV_K - 1, 0)],
        dimension_numbers=('NWC', 'WIO', 'NWC'), feature_group_count=CONV_CHANNELS)
    sc = gate_b * conv
    return jnp.concatenate([att, sc], axis=-1) @ w_out


def mixer_s5(u, lam_re, lam_im, log_dt, b_re, b_im, c_re, c_im, d_skip, w_a, w_b):
    bsz, seq, dm = u.shape
    uf = u.astype(jnp.float32).reshape(bsz, seq, S5_GROUPS, S5_GROUP)
    lr = lam_re.astype(jnp.float32)
    li = lam_im.astype(jnp.float32)
    dt = jnp.exp(log_dt.astype(jnp.float32))[:, None]
    mag = jnp.exp(lr * dt)
    ar = mag * jnp.cos(li * dt)
    ai = mag * jnp.sin(li * dt)
    den = lr * lr + li * li
    fr = ((ar - 1.0) * lr + ai * li) / den
    fi = (ai * lr - (ar - 1.0) * li) / den
    br = b_re.astype(jnp.float32)
    bi = b_im.astype(jnp.float32)
    bbar_re = fr[..., None] * br - fi[..., None] * bi
    bbar_im = fr[..., None] * bi + fi[..., None] * br
    bu_re = jnp.einsum('bsgc,gpc->bsgp', uf, bbar_re)
    bu_im = jnp.einsum('bsgc,gpc->bsgp', uf, bbar_im)
    a_re = jnp.broadcast_to(ar[None, None], (1, seq, S5_GROUPS, S5_STATE))
    a_im = jnp.broadcast_to(ai[None, None], (1, seq, S5_GROUPS, S5_STATE))

    def combine(e1, e2):
        a1r, a1i, b1r, b1i = e1
        a2r, a2i, b2r, b2i = e2
        return (a2r * a1r - a2i * a1i,
                a2r * a1i + a2i * a1r,
                a2r * b1r - a2i * b1i + b2r,
                a2r * b1i + a2i * b1r + b2i)

    _, _, s_re, s_im = lax.associative_scan(combine, (a_re, a_im, bu_re, bu_im), axis=1)
    y = (jnp.einsum('bsgp,gcp->bsgc', s_re, c_re.astype(jnp.float32))
         - jnp.einsum('bsgp,gcp->bsgc', s_im, c_im.astype(jnp.float32)))
    y = y + d_skip.astype(jnp.float32).reshape(S5_GROUPS, S5_GROUP) * uf
    y = jax.nn.gelu(y.reshape(bsz, seq, dm)).astype(u.dtype)
    return (y @ w_a) * jax.nn.sigmoid(y @ w_b)


def setup_inputs(seed: int = 0) -> dict:
    key = jax.random.key(seed)
    ks = jax.random.split(key, 24)
    f32 = jnp.float32
    nrm = lambda k, shape, scale: jax.random.normal(k, shape, f32) * scale
    x = jax.random.normal(ks[0], (BATCH, SEQ, D_MODEL), f32)
    ln_ffn_pre = 1.0 + nrm(ks[1], (DEPTH, D_MODEL), 0.01)
    ln_mix = 1.0 + nrm(ks[2], (DEPTH, D_MODEL), 0.01)
    ln_ffn_post = 1.0 + nrm(ks[3], (DEPTH, D_MODEL), 0.01)
    ln_final = 1.0 + nrm(ks[4], (D_MODEL,), 0.01)
    ffn_w1 = nrm(ks[5], (DEPTH, 2, D_MODEL, D_FF), D_MODEL ** -0.5)
    ffn_w3 = nrm(ks[6], (DEPTH, 2, D_MODEL, D_FF), D_MODEL ** -0.5)
    ffn_w2 = nrm(ks[7], (DEPTH, 2, D_FF, D_MODEL), D_FF ** -0.5)
    ab_w_in = nrm(ks[8], (N_AB, D_MODEL, IN_WIDTH), D_MODEL ** -0.5)
    ab_conv_w = nrm(ks[9], (N_AB, CONV_K, CONV_CHANNELS), CONV_K ** -0.5)
    ab_w_out = nrm(ks[10], (N_AB, MIX_WIDTH, D_MODEL), MIX_WIDTH ** -0.5)
    s5_lambda_re = -0.5 + nrm(ks[11], (N_C, S5_GROUPS, S5_STATE), 0.01)
    s5_lambda_im = (math.pi * jnp.arange(S5_STATE, dtype=f32))[None, None, :] + nrm(
        ks[12], (N_C, S5_GROUPS, S5_STATE), 0.01)
    s5_log_dt = jax.random.uniform(ks[13], (N_C, S5_GROUPS), f32,
                                   minval=math.log(1e-3), maxval=math.log(1e-1))
    s5_b_re = nrm(ks[14], (N_C, S5_GROUPS, S5_STATE, S5_GROUP), (2 * S5_GROUP) ** -0.5)
    s5_b_im = nrm(ks[15], (N_C, S5_GROUPS, S5_STATE, S5_GROUP), (2 * S5_GROUP) ** -0.5)
    s5_c_re = nrm(ks[16], (N_C, S5_GROUPS, S5_GROUP, S5_STATE), (2 * S5_STATE) ** -0.5)
    s5_c_im = nrm(ks[17], (N_C, S5_GROUPS, S5_GROUP, S5_STATE), (2 * S5_STATE) ** -0.5)
    s5_d = nrm(ks[18], (N_C, D_MODEL), 1.0)
    s5_glu_wa = nrm(ks[19], (N_C, D_MODEL, D_MODEL), D_MODEL ** -0.5)
    s5_glu_wb = nrm(ks[20], (N_C, D_MODEL, D_MODEL), D_MODEL ** -0.5)
    return {'x': x, 'ln_ffn_pre': ln_ffn_pre, 'ln_mix': ln_mix, 'ln_ffn_post': ln_ffn_post,
            'ln_final': ln_final, 'ffn_w1': ffn_w1, 'ffn_w3': ffn_w3, 'ffn_w2': ffn_w2,
            'ab_w_in': ab_w_in, 'ab_conv_w': ab_conv_w, 'ab_w_out': ab_w_out,
            's5_lambda_re': s5_lambda_re, 's5_lambda_im': s5_lambda_im, 's5_log_dt': s5_log_dt,
            's5_b_re': s5_b_re, 's5_b_im': s5_b_im, 's5_c_re': s5_c_re, 's5_c_im': s5_c_im,
            's5_d': s5_d, 's5_glu_wa': s5_glu_wa, 's5_glu_wb': s5_glu_wb}


def reference(x, ln_ffn_pre, ln_mix, ln_ffn_post, ln_final, ffn_w1, ffn_w3, ffn_w2,
              ab_w_in, ab_conv_w, ab_w_out, s5_lambda_re, s5_lambda_im, s5_log_dt,
              s5_b_re, s5_b_im, s5_c_re, s5_c_im, s5_d, s5_glu_wa, s5_glu_wb):
    cos, sin = rope_tables(x.shape[1])
    h = x
    for i in range(DEPTH):
        h = h + 0.5 * swiglu(rmsnorm(h, ln_ffn_pre[i]), ffn_w1[i, 0], ffn_w3[i, 0], ffn_w2[i, 0])
        u = rmsnorm(h, ln_mix[i])
        j = i // 2
        if i % 2 == 0:
            h = h + mixer_attn_conv(u, ab_w_in[j], ab_conv_w[j], ab_w_out[j], cos, sin)
        else:
            h = h + mixer_s5(u, s5_lambda_re[j], s5_lambda_im[j], s5_log_dt[j],
                             s5_b_re[j], s5_b_im[j], s5_c_re[j], s5_c_im[j],
                             s5_d[j], s5_glu_wa[j], s5_glu_wb[j])
        h = h + 0.5 * swiglu(rmsnorm(h, ln_ffn_post[i]), ffn_w1[i, 1], ffn_w3[i, 1], ffn_w2[i, 1])
    return rmsnorm(h, ln_final)
```

```cpp
#include <hip/hip_runtime.h>
#include <hip/hip_cooperative_groups.h>
#include <cstdio>
#include <cstdint>
namespace cg = cooperative_groups;
namespace pg8 {
#define PG8_LAS __attribute__((address_space(3)))
typedef unsigned short bf16_t;
typedef short bf16x8 __attribute__((ext_vector_type(8)));
typedef float f32x4 __attribute__((ext_vector_type(4)));
typedef unsigned u32x4 __attribute__((ext_vector_type(4)));
constexpr int BM = 256, BK = 64, HALF = 128, HTB = HALF * BK * 2  , STAGE_BYTES = 8 * HTB, NXCD = 8, WGM = 8;

__host__ __device__ __forceinline__ int lds_byte(int r, int c) { const int st = (r >> 4) * 2 + (c >> 5), rr = r & 15, cc = c & 31, ob = rr * 64 + cc * 2; return st * 1024 + (ob ^ (((ob >> 9) & 1) << 5)); }
__host__ __device__ __forceinline__ void stage_rc(int b, int& R, int& C) { const int st = b / 1024, sb = b % 1024, swz = sb ^ (((sb >> 9) & 1) << 5); R = (st >> 1) * 16 + swz / 64; C = (st & 1) * 32 + (swz % 64) / 2; }
__host__ __device__ __forceinline__ int perm32(int rho) { const int n = rho >> 4, i = rho & 15; return 8 * (i >> 2) + 4 * n + (i & 3); }

struct Unit { int pm, pn; };
struct Gemm { const bf16_t* A; const bf16_t* Bt; int M, N, K; };

struct StaticOrder {
    int nM, nN, nwg, G, c, rev, wgm;
    __host__ __device__ void init(int M, int N, int G_, int c_, int rev_ = 0, int wgm_ = WGM) { nM = M / BM; nN = N / BM; nwg = nM * nN; G = G_; c = c_; rev = (rev_ && nwg % G_ == 0) ? 1 : 0; wgm = wgm_; }
    __host__ __device__ bool next(int i, Unit& u) const {
        const int nr = nwg / G; if (rev) { if (i >= nr) return false; i = nr - 1 - i; }
        const long L = (long)i * G + c; if (L >= nwg) return false;
        int wgid = (int)L; { const int q = nwg / NXCD, r = nwg % NXCD, xcd = wgid % NXCD, off = wgid / NXCD; wgid = (xcd < r ? xcd * (q + 1) : r * (q + 1) + (xcd - r) * q) + off; }
        const int nig = wgm * nN, gid = wgid / nig, fm = gid * wgm, gsz = (nM - fm) < wgm ? (nM - fm) : wgm;
        u.pm = fm + ((wgid % nig) % gsz); u.pn = (wgid % nig) / gsz; return true;
    }
    __device__ __forceinline__ void a_ready(const Unit&) const {}
    __device__ __forceinline__ void done(const Unit&) const {}
};

__device__ __forceinline__ unsigned cvt_pk_bf16(float lo, float hi) { unsigned r; asm volatile("v_cvt_pk_bf16_f32 %0, %1, %2" : "=v"(r) : "v"(lo), "v"(hi)); return r; }
typedef unsigned u32x2 __attribute__((ext_vector_type(2)));
typedef float f32x2_t __attribute__((ext_vector_type(2))); typedef __bf16 bf16x2_t __attribute__((ext_vector_type(2)));
__device__ __forceinline__ unsigned cvtpk(float lo, float hi) { f32x2_t v = {lo, hi}; bf16x2_t b = __builtin_convertvector(v, bf16x2_t); return __builtin_bit_cast(unsigned, b); }
__device__ __forceinline__ float sigmoid_f(float x) { return __builtin_amdgcn_rcpf(1.0f + __builtin_amdgcn_exp2f(-1.4426950408889634f * x)); }
__device__ __forceinline__ float rs_of(float ss) { return __builtin_amdgcn_rsqf(ss * (1.0f / 2048.0f) + 1e-6f); }
__device__ __forceinline__ u32x4 pack8(const f32x4& a, const f32x4& b) { u32x4 w; w.x = cvtpk(a[0], a[1]); w.y = cvtpk(a[2], a[3]); w.z = cvtpk(b[0], b[1]); w.w = cvtpk(b[2], b[3]); return w; }

struct EpiSwiGLU {
    static constexpr bool PERM = true, AFTER_DRAIN = false;
    bf16_t* O; int ldc; const float* SS;
    __device__ __forceinline__ void operator()(const f32x4 (&acc)[2][2][4][2], const Unit& u, int wr, int wc, int fr, int fq) const {
        const int row0 = u.pm * BM + wr * 64 + fr, col0 = u.pn * HALF + wc * 32 + 8 * fq;
#pragma unroll
        for (int ai = 0; ai < 2; ++ai)
#pragma unroll
            for (int m = 0; m < 4; ++m) { const int row = row0 + ai * HALF + m * 16; bf16_t* rowp = O + (size_t)row * ldc + col0;
                const float rs = rs_of(SS[row]);
                f32x4 v[2];
#pragma unroll
                for (int n = 0; n < 2; ++n)
#pragma unroll
                    for (int j = 0; j < 4; ++j) { const float a = acc[ai][0][m][n][j] * rs, b = acc[ai][1][m][n][j] * rs; v[n][j] = a * sigmoid_f(a) * b; }
                *(u32x4*)rowp = pack8(v[0], v[1]); }
    }
};
template <bool NEXT> struct EpiResid {
    static constexpr bool PERM = false, AFTER_DRAIN = false;
    const float* Hin; float* H; int ldc; float scale; const float* gamma; bf16_t* XNo; float* SSo;
    __device__ __forceinline__ void operator()(const f32x4 (&acc)[2][2][4][2], const Unit& u, int wr, int wc, int fr, int fq) const {
        const int row0 = u.pm * BM + wr * 64 + fr, col0 = u.pn * BM + wc * 32 + 4 * fq;
        f32x4 gv[2][2];
        if (NEXT) {
#pragma unroll
            for (int bj = 0; bj < 2; ++bj)
#pragma unroll
                for (int n = 0; n < 2; ++n) gv[bj][n] = *(const f32x4*)(gamma + col0 + bj * HALF + n * 16); }
#pragma unroll
        for (int ai = 0; ai < 2; ++ai)
#pragma unroll
          for (int mh = 0; mh < 2; ++mh) {
            f32x4 hv[2][2][2];
#pragma unroll
            for (int m2 = 0; m2 < 2; ++m2)
#pragma unroll
                for (int bj = 0; bj < 2; ++bj)
#pragma unroll
                    for (int n = 0; n < 2; ++n) hv[m2][bj][n] = *(const f32x4*)(Hin + (size_t)(row0 + ai * HALF + (2 * mh + m2) * 16) * ldc + col0 + bj * HALF + n * 16);
#pragma unroll
            for (int m2 = 0; m2 < 2; ++m2) { const int m = 2 * mh + m2; const int row = row0 + ai * HALF + m * 16; float* rowp = H + (size_t)row * ldc + col0; float ss = 0.f;
#pragma unroll
                for (int bj = 0; bj < 2; ++bj)
#pragma unroll
                    for (int n = 0; n < 2; ++n) { const f32x4 v = hv[m2][bj][n] + scale * acc[ai][bj][m][n]; *(f32x4*)(rowp + bj * HALF + n * 16) = v;
                        if (NEXT) { ss += (v[0] * v[0] + v[1] * v[1]) + (v[2] * v[2] + v[3] * v[3]); const f32x4 w = v * gv[bj][n];
                            u32x2 o; o.x = cvtpk(w[0], w[1]); o.y = cvtpk(w[2], w[3]); *(u32x2*)(XNo + (size_t)row * ldc + col0 + bj * HALF + n * 16) = o; } }
                if (NEXT) { ss += __shfl_xor(ss, 16); ss += __shfl_xor(ss, 32); if (fq == 0) unsafeAtomicAdd(SSo + row, ss); } }
            asm volatile("" ::: "memory"); }
    }
};
struct EpiGLU {
    static constexpr bool PERM = false, AFTER_DRAIN = false;
    float* H; int ldc; const float* gamma; bf16_t* XNo; float* SSo;
    __device__ __forceinline__ void operator()(const f32x4 (&acc)[2][2][4][2], const Unit& u, int wr, int wc, int fr, int fq) const {
        const int row0 = u.pm * BM + wr * 64 + fr, col0 = u.pn * HALF + wc * 32 + 4 * fq;
        f32x4 gv[2];
#pragma unroll
        for (int n = 0; n < 2; ++n) gv[n] = *(const f32x4*)(gamma + col0 + n * 16);
#pragma unroll
        for (int ai = 0; ai < 2; ++ai) {
            f32x4 hv[4][2];
#pragma unroll
            for (int m = 0; m < 4; ++m)
#pragma unroll
                for (int n = 0; n < 2; ++n) hv[m][n] = *(const f32x4*)(H + (size_t)(row0 + ai * HALF + m * 16) * ldc + col0 + n * 16);
#pragma unroll
            for (int m = 0; m < 4; ++m) { const int row = row0 + ai * HALF + m * 16; float* rowp = H + (size_t)row * ldc + col0; float ss = 0.f;
#pragma unroll
                for (int n = 0; n < 2; ++n) { f32x4 v = hv[m][n];
#pragma unroll
                    for (int j = 0; j < 4; ++j) v[j] += acc[ai][0][m][n][j] * sigmoid_f(acc[ai][1][m][n][j]);
                    *(f32x4*)(rowp + n * 16) = v; ss += (v[0] * v[0] + v[1] * v[1]) + (v[2] * v[2] + v[3] * v[3]); const f32x4 w = v * gv[n];
                    u32x2 o; o.x = cvtpk(w[0], w[1]); o.y = cvtpk(w[2], w[3]); *(u32x2*)(XNo + (size_t)row * ldc + col0 + n * 16) = o; }
                ss += __shfl_xor(ss, 16); ss += __shfl_xor(ss, 32); if (fq == 0) unsafeAtomicAdd(SSo + row, ss); }
            asm volatile("" ::: "memory"); }
    }
};
struct EpiInProj {
    static constexpr bool PERM = true, AFTER_DRAIN = false;
    bf16_t *Q, *K, *V, *GB, *U; const float* cs;
    float qscale; const float* SS;
    __device__ __forceinline__ void operator()(const f32x4 (&acc)[2][2][4][2], const Unit& u, int wr, int wc, int fr, int fq) const {
        const int row0 = u.pm * BM + wr * 64 + fr;
        if (u.pn < 8) {
            bf16_t* dst = u.pn < 4 ? Q : K; const float sc = u.pn < 4 ? qscale : 1.0f;
            const int head = 2 * (u.pn & 3) + (wc >> 1), j0 = 32 * (wc & 1) + 8 * fq;
#pragma unroll
            for (int ai = 0; ai < 2; ++ai)
#pragma unroll
                for (int m = 0; m < 4; ++m) { const int row = row0 + ai * HALF + m * 16, pos = row & 2047; const float rsc = rs_of(SS[row]) * sc;
                    const f32x4* cp = (const f32x4*)(cs + pos * 64 + j0); const f32x4* sp = (const f32x4*)(cs + 2048 * 64 + pos * 64 + j0);
                    f32x4 o1[2], o2[2];
#pragma unroll
                    for (int n = 0; n < 2; ++n) { const f32x4 c = cp[n], s = sp[n], t1 = acc[ai][0][m][n], t2 = acc[ai][1][m][n];
                        o1[n] = (t1 * c - t2 * s) * rsc; o2[n] = (t2 * c + t1 * s) * rsc; }
                    bf16_t* rowp = dst + (size_t)row * 1024 + head * 128 + j0;
                    *(u32x4*)rowp = pack8(o1[0], o1[1]); *(u32x4*)(rowp + 64) = pack8(o2[0], o2[1]);
                    asm volatile("" ::: "memory"); }
        } else if (u.pn < 16) {
            bf16_t* dst = u.pn < 12 ? V : GB; const int col0 = (u.pn & 3) * BM + wc * 32 + 8 * fq;
#pragma unroll
            for (int ai = 0; ai < 2; ++ai)
#pragma unroll
                for (int m = 0; m < 4; ++m) { const int row = row0 + ai * HALF + m * 16; bf16_t* rowp = dst + (size_t)row * 1024 + col0; const float rs = rs_of(SS[row]);
#pragma unroll
                    for (int bj = 0; bj < 2; ++bj) *(u32x4*)(rowp + bj * HALF) = pack8(acc[ai][bj][m][0] * rs, acc[ai][bj][m][1] * rs); }
        } else {
            const int col0 = (u.pn - 16) * HALF + wc * 32 + 8 * fq;
#pragma unroll
            for (int ai = 0; ai < 2; ++ai)
#pragma unroll
                for (int m = 0; m < 4; ++m) { const int row = row0 + ai * HALF + m * 16; bf16_t* rowp = U + (size_t)row * 1024 + col0; const float rs = rs_of(SS[row]), rs2 = rs * rs;
                    *(u32x4*)rowp = pack8(acc[ai][0][m][0] * acc[ai][1][m][0] * rs2, acc[ai][0][m][1] * acc[ai][1][m][1] * rs2); }
        }
    }
};
template <class Epi, class Sched, bool ALIGN_EPI = false, bool SP2 = false>
__device__ __forceinline__ void gemm_phase(PG8_LAS unsigned char* lds, const Gemm g, const Sched& S, const Epi& E) {
    const int tid = threadIdx.x, wid = __builtin_amdgcn_readfirstlane(tid >> 6), lane = tid & 63, wr = wid >> 2, wc = wid & 3, fr = lane & 15, fq = lane >> 4;
    const int K = g.K, nt = K / BK;
    unsigned voffA[2], voffB[2];
#pragma unroll
    for (int i = 0; i < 2; ++i) { int R, C; stage_rc(tid * 16 + i * 8192, R, C); const int Rb = Epi::PERM ? ((R & ~31) + perm32(R & 31)) : R;
        voffA[i] = (unsigned)(R * K + C) * 2u; voffB[i] = (unsigned)(Rb * K + C) * 2u; }
    const size_t kstep = (size_t)(BK * 2);
    const size_t hstep = (size_t)HALF * K * 2;
    const size_t tstep = 2 * hstep;
    const unsigned ldsw = (unsigned)wid * 1024u;
    const int aoff = lds_byte(wr * 64 + fr, fq * 8), boff = lds_byte(wc * 32 + fr, fq * 8);
#define PG8_SA(b, h) (((b) * 2 + (h)) * HTB)
#define PG8_SB(b, h) ((4 + (b) * 2 + (h)) * HTB)
#define PG8_STAGE(bufoff, gbase, voff) do { _Pragma("unroll") for (int _i = 0; _i < 2; ++_i) \
        __builtin_amdgcn_global_load_lds((const unsigned*)((const char*)(gbase) + (voff)[_i]), (PG8_LAS unsigned*)(lds + (bufoff) + ldsw + _i * 8192), 16, 0, 0); } while (0)
#define PG8_LDA(dst, b, h) do { _Pragma("unroll") for (int m = 0; m < 4; ++m) _Pragma("unroll") for (int k = 0; k < 2; ++k) dst[m][k] = *(const PG8_LAS bf16x8*)(lds + PG8_SA(b, h) + aoff + m * 2048 + k * 1024); } while (0)
#define PG8_LDB(dst, b, h) do { _Pragma("unroll") for (int n = 0; n < 2; ++n) _Pragma("unroll") for (int k = 0; k < 2; ++k) dst[n][k] = *(const PG8_LAS bf16x8*)(lds + PG8_SB(b, h) + boff + n * 2048 + k * 1024); } while (0)
#define PG8_MMA(ai, bj, At, Bt) do { __builtin_amdgcn_s_setprio(1); _Pragma("unroll") for (int m = 0; m < 4; ++m) _Pragma("unroll") for (int n = 0; n < 2; ++n) _Pragma("unroll") for (int k = 0; k < 2; ++k) \
        acc[ai][bj][m][n] = __builtin_amdgcn_mfma_f32_16x16x32_bf16(Bt[n][k], At[m][k], acc[ai][bj][m][n], 0, 0, 0); __builtin_amdgcn_s_setprio(0); } while (0)
#define PG8_WAIT_V(n) asm volatile("s_waitcnt vmcnt(" #n ")" ::: "memory")
#define PG8_WAIT_L(n) asm volatile("s_waitcnt lgkmcnt(" #n ")" ::: "memory")
#define PG8_BAR __builtin_amdgcn_s_barrier()
#define PG8_SCHED __builtin_amdgcn_sched_barrier(0)
    Unit cur, nxt; int ui = 0;
    if (!S.next(0, cur)) return;
    f32x4 acc[2][2][4][2];
#pragma unroll
    for (int a = 0; a < 2; ++a)
#pragma unroll
        for (int b = 0; b < 2; ++b)
#pragma unroll
            for (int m = 0; m < 4; ++m)
#pragma unroll
                for (int n = 0; n < 2; ++n) acc[a][b][m][n] = (f32x4){0.f, 0.f, 0.f, 0.f};
    bf16x8 At[4][2], B0[2][2], B1[2][2];
    const char* cA = (const char*)g.A + (size_t)cur.pm * tstep; const char* cB = (const char*)g.Bt + (size_t)cur.pn * tstep;
    S.a_ready(cur);
    if constexpr (SP2) {
        PG8_STAGE(PG8_SB(0, 0), cB, voffB); PG8_STAGE(PG8_SB(0, 1), cB + hstep, voffB); PG8_STAGE(PG8_SA(0, 0), cA, voffA); PG8_STAGE(PG8_SA(0, 1), cA + hstep, voffA);
        if (wr == 1) PG8_BAR;
        PG8_WAIT_V(2); PG8_BAR;
        PG8_STAGE(PG8_SB(1, 0), cB + kstep, voffB); PG8_STAGE(PG8_SA(1, 0), cA + kstep, voffA); PG8_STAGE(PG8_SB(1, 1), cB + hstep + kstep, voffB);
        PG8_WAIT_V(6); PG8_BAR;
    } else {
        PG8_STAGE(PG8_SB(0, 0), cB, voffB); PG8_STAGE(PG8_SA(0, 0), cA, voffA); PG8_STAGE(PG8_SB(0, 1), cB + hstep, voffB); PG8_STAGE(PG8_SA(0, 1), cA + hstep, voffA);
        if (wr == 1) PG8_BAR;
        PG8_WAIT_V(4); PG8_BAR;
        PG8_STAGE(PG8_SB(1, 0), cB + kstep, voffB); PG8_STAGE(PG8_SA(1, 0), cA + kstep, voffA); PG8_STAGE(PG8_SB(1, 1), cB + hstep + kstep, voffB);
        PG8_WAIT_V(6); PG8_BAR;
    }
    for (;;) {
        const bool has_next = S.next(ui + 1, nxt);
        const char* nA = has_next ? (const char*)g.A + (size_t)nxt.pm * tstep : cA; const char* nB = has_next ? (const char*)g.Bt + (size_t)nxt.pn * tstep : cB;
        for (int t = 0; t < nt; t += 2) {
            const bool last = (t == nt - 2);
            const char* a1 = cA + (size_t)(t + 1) * kstep;
            const char* a2 = last ? nA : cA + (size_t)(t + 2) * kstep; const char* b2 = last ? nB : cB + (size_t)(t + 2) * kstep;
            const char* a3 = a2 + kstep; const char* b3 = b2 + kstep;
            if (last && has_next) S.a_ready(nxt);
            if constexpr (SP2) {
            PG8_LDB(B0, 0, 0); PG8_LDB(B1, 0, 1); PG8_SCHED; PG8_LDA(At, 0, 0); PG8_STAGE(PG8_SA(1, 1), a1 + hstep, voffA);
            PG8_WAIT_V(8); PG8_WAIT_L(0); PG8_BAR; PG8_MMA(0, 0, At, B0); PG8_MMA(0, 1, At, B1); PG8_BAR; PG8_SCHED;
            PG8_LDA(At, 0, 1); PG8_STAGE(PG8_SB(0, 0), b2, voffB); PG8_STAGE(PG8_SB(0, 1), b2 + hstep, voffB); PG8_STAGE(PG8_SA(0, 0), a2, voffA);
            PG8_WAIT_V(8); PG8_WAIT_L(0); PG8_BAR; PG8_MMA(1, 0, At, B0); PG8_MMA(1, 1, At, B1); PG8_BAR; PG8_SCHED;
            PG8_LDB(B0, 1, 0); PG8_LDB(B1, 1, 1); PG8_SCHED; PG8_LDA(At, 1, 0); PG8_STAGE(PG8_SA(0, 1), a2 + hstep, voffA);
            PG8_WAIT_V(8); PG8_WAIT_L(0); PG8_BAR; PG8_MMA(0, 0, At, B0); PG8_MMA(0, 1, At, B1); PG8_BAR; PG8_SCHED;
            PG8_LDA(At, 1, 1); PG8_STAGE(PG8_SB(1, 0), b3, voffB); PG8_STAGE(PG8_SB(1, 1), b3 + hstep, voffB); PG8_STAGE(PG8_SA(1, 0), a3, voffA);
            PG8_WAIT_V(8); PG8_WAIT_L(0); PG8_BAR; PG8_MMA(1, 0, At, B0); PG8_MMA(1, 1, At, B1); PG8_BAR; PG8_SCHED;
            } else {
            PG8_LDB(B0, 0, 0); PG8_SCHED; PG8_LDA(At, 0, 0); PG8_STAGE(PG8_SA(1, 1), a1 + hstep, voffA);
            PG8_WAIT_L(8); PG8_BAR; PG8_WAIT_L(0); PG8_MMA(0, 0, At, B0); PG8_BAR; PG8_SCHED;
            PG8_LDB(B1, 0, 1); PG8_STAGE(PG8_SB(0, 0), b2, voffB);
            PG8_BAR; PG8_WAIT_L(0); PG8_MMA(0, 1, At, B1); PG8_BAR;
            PG8_LDA(At, 0, 1); PG8_STAGE(PG8_SA(0, 0), a2, voffA);
            PG8_BAR; PG8_WAIT_L(0); PG8_MMA(1, 0, At, B0); PG8_BAR; PG8_SCHED;
            PG8_STAGE(PG8_SB(0, 1), b2 + hstep, voffB);
            PG8_WAIT_V(6); PG8_BAR; PG8_MMA(1, 1, At, B1); PG8_BAR;
            PG8_LDB(B0, 1, 0); PG8_SCHED; PG8_LDA(At, 1, 0); PG8_STAGE(PG8_SA(0, 1), a2 + hstep, voffA);
            PG8_WAIT_L(8); PG8_BAR; PG8_WAIT_L(0); PG8_MMA(0, 0, At, B0); PG8_BAR; PG8_SCHED;
            PG8_LDB(B1, 1, 1); PG8_STAGE(PG8_SB(1, 0), b3, voffB);
            PG8_BAR; PG8_WAIT_L(0); PG8_MMA(0, 1, At, B1); PG8_BAR;
            PG8_LDA(At, 1, 1); PG8_STAGE(PG8_SA(1, 0), a3, voffA);
            PG8_BAR; PG8_WAIT_L(0); PG8_MMA(1, 0, At, B0); PG8_BAR; PG8_SCHED;
            PG8_STAGE(PG8_SB(1, 1), b3 + hstep, voffB);
            PG8_WAIT_V(6); PG8_BAR; PG8_MMA(1, 1, At, B1); PG8_BAR;
            }
        }
        if constexpr (ALIGN_EPI) { if (wr == 0) PG8_BAR; }
        if constexpr (!Epi::AFTER_DRAIN) { E(acc, cur, wr, wc, fr, fq); S.done(cur); }
        if (!has_next) break;
#pragma unroll
        for (int a = 0; a < 2; ++a)
#pragma unroll
            for (int b = 0; b < 2; ++b)
#pragma unroll
                for (int m = 0; m < 4; ++m)
#pragma unroll
                    for (int n = 0; n < 2; ++n) acc[a][b][m][n] = (f32x4){0.f, 0.f, 0.f, 0.f};
        cur = nxt; cA = nA; cB = nB; ++ui;
        if constexpr (ALIGN_EPI) { if (wr == 1) PG8_BAR; }
    }
    PG8_WAIT_V(0);
    if constexpr (!ALIGN_EPI) { if (wr == 0) PG8_BAR; }
    PG8_BAR;
    if constexpr (Epi::AFTER_DRAIN) { E.fused(acc, cur, wr, wc, fr, fq, lds, wid, lane); S.done(cur); }
#undef PG8_SA
#undef PG8_SB
#undef PG8_STAGE
#undef PG8_LDA
#undef PG8_LDB
#undef PG8_MMA
#undef PG8_WAIT_V
#undef PG8_WAIT_L
#undef PG8_BAR
#undef PG8_SCHED
}
}
#define LAS __attribute__((address_space(3)))
using pg8::bf16_t; using pg8::f32x4; using pg8::u32x4; using pg8::bf16x8; using pg8::cvtpk; using pg8::sigmoid_f; using pg8::rs_of;
typedef float f32x16 __attribute__((ext_vector_type(16)));
typedef float f32x2 __attribute__((ext_vector_type(2)));
typedef short s16x4 __attribute__((ext_vector_type(4)));
using pg8::u32x2;

constexpr int M_ = 32768, DM = 2048, FF = 5632, SEQ = 2048;
constexpr float RMS_EPS = 1e-6f;
constexpr size_t MiB = 1ull << 20;
constexpr size_t WS_CS = 0;
constexpr size_t WS_S5A = 1 * MiB;
constexpr size_t WS_GRP = 1 * MiB + 64 * 1024;
constexpr size_t WS_SS = 1 * MiB + 128 * 1024;
constexpr size_t WS_S5B = 2 * MiB;
constexpr size_t WS_S5C = 3 * MiB;
constexpr size_t WS_W13 = 4 * MiB;  constexpr size_t W13_SZ = (size_t)2 * FF * DM * 2;
constexpr size_t WS_W2 = WS_W13 + 4 * W13_SZ;  constexpr size_t W2_SZ = (size_t)DM * FF * 2;
constexpr size_t WS_WIN = WS_W2 + 4 * W2_SZ;
constexpr size_t WS_WOUT = WS_WIN + (size_t)6144 * DM * 2;
constexpr size_t WS_WAB = WS_WOUT + (size_t)DM * DM * 2;
constexpr size_t WS_XN = WS_WAB + (size_t)4096 * DM * 2;
constexpr size_t WS_BIG = WS_XN + (size_t)M_ * DM * 2;
constexpr size_t WS_CAT = WS_BIG + (size_t)M_ * FF * 2;
constexpr size_t WS_END = WS_CAT + (size_t)M_ * DM * 2;
constexpr size_t PROJ_SZ = (size_t)M_ * 1024 * 2;
static_assert(5 * PROJ_SZ <= (size_t)M_ * FF * 2 && WS_END <= 1024 * MiB, "d_ws map");
constexpr int LDS_BYTES = 147456;

struct Args { const float* in[21]; float* out; unsigned char* ws; };

__device__ __forceinline__ float bf_lo(unsigned u) { return __uint_as_float(u << 16); }
__device__ __forceinline__ float bf_hi(unsigned u) { return __uint_as_float(u & 0xffff0000u); }
__device__ __forceinline__ float wave_sum(float v) {
#pragma unroll
    for (int o = 1; o < 64; o <<= 1) v += __shfl_xor(v, o);
    return v;
}
#define LDS_WAIT() asm volatile("s_waitcnt lgkmcnt(0)" ::: "memory")

__device__ __forceinline__ const float* src_base(const Args& a, int seg, int n0, int& ld) {
    if (seg < 4) { const int tile = n0 >> 8, within = n0 & 255, half = within >> 7, j = tile * 128 + (within & 127);
        ld = FF; return (half ? a.in[6] : a.in[5]) + (size_t)seg * DM * FF + j; }
    if (seg < 8) { ld = DM; return a.in[7] + (size_t)(seg - 4) * FF * DM + n0; }
    if (seg == 8) { ld = 6144; const int pn = n0 >> 8, within = n0 & 255, half = within >> 7, cc = within & 127; int col;
        if (pn < 8) { const int sec = pn >> 2, head = 2 * (pn & 3) + (cc >> 6), dim = (cc & 63) + 64 * half; col = sec * 1024 + head * 128 + dim; }
        else if (pn < 16) col = n0;
        else col = (half ? 5120 : 4096) + (pn - 16) * 128 + cc;
        return a.in[8] + col; }
    if (seg == 9) { ld = DM; return a.in[10] + n0; }
    { const int tile = n0 >> 8, within = n0 & 255, half = within >> 7, j = tile * 128 + (within & 127); ld = DM; return (half ? a.in[20] : a.in[19]) + j; }
}
__device__ __forceinline__ void transpose_item(const float* W, int ld, bf16_t* WT, int K, int n0, int k0, LAS float* scr, int lane) {
#pragma unroll 8
    for (int i = 0; i < 32; ++i) { const int kk = 2 * i + (lane >> 5); scr[kk * 33 + (lane & 31)] = W[(size_t)(k0 + kk) * ld + (lane & 31)]; }
    LDS_WAIT();
    const int c = lane & 7;
#pragma unroll
    for (int j = 0; j < 4; ++j) { const int n = (lane >> 3) + 8 * j; const LAS float* s = scr + (8 * c) * 33 + n;
        u32x4 o; o.x = cvtpk(s[0 * 33], s[1 * 33]); o.y = cvtpk(s[2 * 33], s[3 * 33]); o.z = cvtpk(s[4 * 33], s[5 * 33]); o.w = cvtpk(s[6 * 33], s[7 * 33]);
        *(u32x4*)(WT + (size_t)(n0 + n) * K + k0 + 8 * c) = o; }
    LDS_WAIT();
}
__device__ __forceinline__ void p0_weights(const Args& a, LAS unsigned char* lds, int gw, int NGW, int wave, int lane) {
    LAS float* scr = (LAS float*)(lds + wave * 8448);
    constexpr int I13 = (2 * FF / 32) * (DM / 64), I2 = (DM / 32) * (FF / 64), IIN = (6144 / 32) * (DM / 64), IOUT = (DM / 32) * (DM / 64), IAB = (4096 / 32) * (DM / 64);
    constexpr int TOTAL = 4 * I13 + 4 * I2 + IIN + IOUT + IAB;
    for (int it = gw; it < TOTAL; it += NGW) {
        int r = it, seg, rows, K; bf16_t* dst;
        if (r < 4 * I13) { seg = r / I13; r -= seg * I13; rows = 2 * FF; K = DM; dst = (bf16_t*)(a.ws + WS_W13 + (size_t)seg * W13_SZ); }
        else { r -= 4 * I13;
            if (r < 4 * I2) { const int i = r / I2; r -= i * I2; seg = 4 + i; rows = DM; K = FF; dst = (bf16_t*)(a.ws + WS_W2 + (size_t)i * W2_SZ); }
            else { r -= 4 * I2;
                if (r < IIN) { seg = 8; rows = 6144; K = DM; dst = (bf16_t*)(a.ws + WS_WIN); }
                else { r -= IIN;
                    if (r < IOUT) { seg = 9; rows = DM; K = DM; dst = (bf16_t*)(a.ws + WS_WOUT); }
                    else { r -= IOUT; seg = 10; rows = 4096; K = DM; dst = (bf16_t*)(a.ws + WS_WAB); } } } }
        const int nblk = rows / 32, nb = r % nblk, kb = r / nblk; int ld;
        const float* W = src_base(a, seg, nb * 32, ld);
        transpose_item(W, ld, dst, K, nb * 32, kb * 64, scr, lane);
    }
}
__device__ __forceinline__ void p0_tables(const Args& a, int gtid, int NT) {
    float* cs = (float*)(a.ws + WS_CS);
    for (int i = gtid; i < SEQ * 64; i += NT) { const int pos = i >> 6, j = i & 63;
        const float inv = (float)pow(10000.0, -(double)j / 64.0); const float ang = (float)pos * inv;
        cs[i] = (float)cos((double)ang); cs[SEQ * 64 + i] = (float)sin((double)ang); }
    float* A = (float*)(a.ws + WS_S5A); float* BT = (float*)(a.ws + WS_S5B); float* CT = (float*)(a.ws + WS_S5C);
    for (int i = gtid; i < 128 * 64; i += NT) { const int g = i >> 6, p = i & 63;
        const double lr = a.in[11][i], li = a.in[12][i], dt = exp((double)a.in[13][g]);
        const double mag = exp(lr * dt), ar = mag * cos(li * dt), ai = mag * sin(li * dt), den = lr * lr + li * li;
        const double fr = ((ar - 1.0) * lr + ai * li) / den, fi = (ai * lr - (ar - 1.0) * li) / den;
        A[2 * i] = (float)ar; A[2 * i + 1] = (float)ai;
        for (int c = 0; c < 16; ++c) { const double br = a.in[14][(size_t)i * 16 + c], bi = a.in[15][(size_t)i * 16 + c];
            BT[((size_t)g * 16 + c) * 128 + 2 * p] = (float)(fr * br - fi * bi); BT[((size_t)g * 16 + c) * 128 + 2 * p + 1] = (float)(fr * bi + fi * br);
            CT[((size_t)g * 128 + 2 * p) * 16 + c] = a.in[16][((size_t)g * 16 + c) * 64 + p]; CT[((size_t)g * 128 + 2 * p + 1) * 16 + c] = -a.in[17][((size_t)g * 16 + c) * 64 + p]; }
    }
}
__device__ __forceinline__ void first_rows(const float* src, float* cpy, const float* gamma, bf16_t* xn, float* ss0, int gw, int NGW, int lane) {
    for (int m = gw; m < M_; m += NGW) {
        const f32x4* xr = (const f32x4*)(src + (size_t)m * DM) + lane; f32x4 v[8]; float s = 0.f;
#pragma unroll
        for (int j = 0; j < 8; ++j) { v[j] = xr[64 * j]; s += (v[j].x * v[j].x + v[j].y * v[j].y) + (v[j].z * v[j].z + v[j].w * v[j].w); }
        s = wave_sum(s); if (lane == 0) ss0[m] = s;
        const f32x4* gr = (const f32x4*)gamma + lane; u32x2* o = (u32x2*)(xn + (size_t)m * DM) + lane;
#pragma unroll
        for (int j = 0; j < 8; ++j) { const f32x4 g = gr[64 * j]; u32x2 w; w.x = cvtpk(v[j].x * g.x, v[j].y * g.y); w.y = cvtpk(v[j].z * g.z, v[j].w * g.w); o[64 * j] = w; }
    }
}
__device__ __forceinline__ void final_norm(float* h, const float* gamma, int m_begin, int m_end, int step, int lane) {
    for (int m = m_begin; m < m_end; m += step) {
        f32x4* xr = (f32x4*)(h + (size_t)m * DM) + lane; f32x4 v[8]; float s = 0.f;
#pragma unroll
        for (int j = 0; j < 8; ++j) { v[j] = xr[64 * j]; s += (v[j].x * v[j].x + v[j].y * v[j].y) + (v[j].z * v[j].z + v[j].w * v[j].w); }
        const float rs = 1.0f / sqrtf(wave_sum(s) * (1.0f / DM) + RMS_EPS);
        const f32x4* gr = (const f32x4*)gamma + lane;
#pragma unroll
        for (int j = 0; j < 8; ++j) xr[64 * j] = v[j] * rs * gr[64 * j];
    }
}
#define MFMA32(a, b, c) __builtin_amdgcn_mfma_f32_32x32x16_bf16((a), (b), (c), 0, 0, 0)
typedef short v4i16_t __attribute__((ext_vector_type(4)));
__device__ __forceinline__ s16x4 vtr(unsigned byte_addr) { return __builtin_bit_cast(s16x4, __builtin_amdgcn_ds_read_tr16_b64_v4i16((LAS v4i16_t*)(size_t)byte_addr)); }
__device__ __forceinline__ void attn_task(const bf16_t* Q, const bf16_t* Kb, const bf16_t* Vb, bf16_t* OB, int ostride, float* LSE, LAS unsigned char* vl, int b, int hd, int lg, int r, int T, int lane) {
    const int qi = lane & 31, h = lane >> 5, lr = lane >> 4, lp = lane & 15;
    const int cq = 32 * T + qi;
    const size_t qrow = (size_t)b * SEQ + (cq << lg) + r;
    const int ckbase = 32 * T - 128;
    int c = ckbase < 0 ? (-ckbase) >> 5 : 0;
#define ATT_ROWPTR(P, ck, it) ((P) + ((size_t)b * SEQ + (((ck) + 4 * (it) + lr) << lg) + r) * 1024 + hd * 128 + 8 * lp)
    u32x4 kr[8], vr[8];
#pragma unroll
    for (int it = 0; it < 8; ++it) kr[it] = *(const u32x4*)ATT_ROWPTR(Q, 32 * T, it);
#pragma unroll
    for (int it = 0; it < 8; ++it) *(LAS u32x4*)(vl + (4 * it + lr) * 272 + 16 * lp) = kr[it];
#pragma unroll
    for (int it = 0; it < 8; ++it) kr[it] = *(const u32x4*)ATT_ROWPTR(Kb, ckbase + 32 * c, it);
#pragma unroll
    for (int it = 0; it < 8; ++it) vr[it] = *(const u32x4*)ATT_ROWPTR(Vb, ckbase + 32 * c, it);
    LDS_WAIT();
#pragma unroll
    for (int ks = 0; ks < 8; ++ks) *(LAS bf16x8*)(vl + 10240 + (ks * 64 + lane) * 16) = *(LAS bf16x8*)(vl + qi * 272 + 32 * ks + 16 * h);
    LDS_WAIT();
    f32x16 o[4];
#pragma unroll
    for (int dc = 0; dc < 4; ++dc)
#pragma unroll
        for (int i = 0; i < 16; ++i) o[dc][i] = 0.f;
    float m_run = -1e30f, l_run = 0.f;
    const int i16 = lane & 15, tq = i16 >> 2, tp = i16 & 3, blk = (lane >> 4) & 1;
    const unsigned vbase = (unsigned)(size_t)vl;
    const unsigned tr_off = vbase + (unsigned)((4 * h + tq) * 320 + 2 * (16 * blk + 4 * tp));
    for (;;) {
        const bool has_next = c < 4;
        const int ck0 = ckbase + 32 * c;
#pragma unroll
        for (int it = 0; it < 8; ++it) *(LAS u32x4*)(vl + (4 * it + lr) * 272 + 16 * lp) = kr[it];
        if (has_next) {
#pragma unroll
            for (int it = 0; it < 8; ++it) kr[it] = *(const u32x4*)ATT_ROWPTR(Kb, ck0 + 32, it); }
        LDS_WAIT();
        f32x16 s;
#pragma unroll
        for (int i = 0; i < 16; ++i) s[i] = 0.f;
#pragma unroll
        for (int ks = 0; ks < 8; ++ks) s = MFMA32(*(LAS bf16x8*)(vl + qi * 272 + 32 * ks + 16 * h), *(LAS bf16x8*)(vl + 10240 + (ks * 64 + lane) * 16), s);
        LDS_WAIT();
#pragma unroll
        for (int it = 0; it < 8; ++it) *(LAS u32x4*)(vl + (4 * it + lr) * 320 + 16 * lp) = vr[it];
        if (has_next) {
#pragma unroll
            for (int it = 0; it < 8; ++it) vr[it] = *(const u32x4*)ATT_ROWPTR(Vb, ck0 + 32, it); }
        float mx = -1e30f;
        if (c == 0 || c == 4) {
#pragma unroll
            for (int i = 0; i < 16; ++i) { const int ck = ck0 + (i & 3) + 8 * (i >> 2) + 4 * h; const bool ok = (ck <= cq) && (ck >= cq - 128); s[i] = ok ? s[i] : -1e30f; } }
#pragma unroll
        for (int i = 0; i < 16; ++i) mx = fmaxf(mx, s[i]);
        mx = fmaxf(mx, __shfl_xor(mx, 32));
        const float m_new = fmaxf(m_run, mx), alpha = __builtin_amdgcn_exp2f(m_run - m_new);
        float ps = 0.f;
#pragma unroll
        for (int i = 0; i < 16; ++i) { const float p = (s[i] > -1e29f) ? __builtin_amdgcn_exp2f(s[i] - m_new) : 0.f; s[i] = p; ps += p; }
        l_run = l_run * alpha + ps; m_run = m_new;
#pragma unroll
        for (int dc = 0; dc < 4; ++dc)
#pragma unroll
            for (int i = 0; i < 16; ++i) o[dc][i] *= alpha;
        bf16x8 pf[2];
#pragma unroll
        for (int s2 = 0; s2 < 2; ++s2) { u32x4 w; w.x = cvtpk(s[8 * s2 + 0], s[8 * s2 + 1]); w.y = cvtpk(s[8 * s2 + 2], s[8 * s2 + 3]); w.z = cvtpk(s[8 * s2 + 4], s[8 * s2 + 5]); w.w = cvtpk(s[8 * s2 + 6], s[8 * s2 + 7]); pf[s2] = __builtin_bit_cast(bf16x8, w); }
        LDS_WAIT();
#pragma unroll
        for (int dc = 0; dc < 4; ++dc)
#pragma unroll
            for (int s2 = 0; s2 < 2; ++s2) {
                const s16x4 lo = vtr(tr_off + (unsigned)(16 * s2 * 320 + 64 * dc)), hi = vtr(tr_off + (unsigned)((16 * s2 + 8) * 320 + 64 * dc));
                const bf16x8 va = __builtin_shufflevector(lo, hi, 0, 1, 2, 3, 4, 5, 6, 7);
                o[dc] = MFMA32(va, pf[s2], o[dc]); }
        LDS_WAIT();
        if (!has_next) break;
        ++c;
    }
#undef ATT_ROWPTR
    const float l = l_run + __shfl_xor(l_run, 32), inv = 1.0f / l;
    if (h == 0) LSE[qrow * 8 + hd] = m_run + __builtin_amdgcn_logf(l);
    bf16_t* op = OB + qrow * ostride + hd * 128 + 4 * h;
#pragma unroll
    for (int dc = 0; dc < 4; ++dc)
#pragma unroll
        for (int g = 0; g < 4; ++g) { u32x2 w; w.x = cvtpk(o[dc][4 * g] * inv, o[dc][4 * g + 1] * inv); w.y = cvtpk(o[dc][4 * g + 2] * inv, o[dc][4 * g + 3] * inv);
            *(u32x2*)(op + 32 * dc + 8 * g) = w; }
}
__device__ __forceinline__ void attn_mix_conv(const bf16_t* O0, const bf16_t* O1, const float* LSE, size_t lse_bs, const bf16_t* U, const bf16_t* GB, const float* cw, bf16_t* CAT, int row_begin, int nrows, int gtid, int NT) {
    for (int idx = gtid; idx < nrows * 128; idx += NT) { const int row = row_begin + (idx >> 7), c8 = (idx & 127) * 8, pos = row & (SEQ - 1), hd = c8 >> 7;
        { const float l0 = LSE[(size_t)row * 8 + hd], l1 = LSE[lse_bs + (size_t)row * 8 + hd], l2 = LSE[2 * lse_bs + (size_t)row * 8 + hd];
          const float mm = fmaxf(l0, fmaxf(l1, l2)); float w0 = __builtin_amdgcn_exp2f(l0 - mm), w1 = __builtin_amdgcn_exp2f(l1 - mm), w2 = __builtin_amdgcn_exp2f(l2 - mm);
          const float iw = 1.0f / (w0 + w1 + w2); w0 *= iw; w1 *= iw; w2 *= iw;
          const u32x4 a0 = *(const u32x4*)(O0 + (size_t)row * 1024 + c8), a1 = *(const u32x4*)(O1 + (size_t)row * 1024 + c8), a2 = *(const u32x4*)(CAT + (size_t)row * DM + c8);
          u32x4 ov;
#pragma unroll
          for (int j = 0; j < 4; ++j) ov[j] = cvtpk(w0 * bf_lo(a0[j]) + w1 * bf_lo(a1[j]) + w2 * bf_lo(a2[j]), w0 * bf_hi(a0[j]) + w1 * bf_hi(a1[j]) + w2 * bf_hi(a2[j]));
          *(u32x4*)(CAT + (size_t)row * DM + c8) = ov; }
        const u32x4 z = {0u, 0u, 0u, 0u};
        const u32x4 u0 = *(const u32x4*)(U + (size_t)row * 1024 + c8), u1 = pos >= 1 ? *(const u32x4*)(U + (size_t)(row - 1) * 1024 + c8) : z, u2 = pos >= 2 ? *(const u32x4*)(U + (size_t)(row - 2) * 1024 + c8) : z;
        const u32x4 gb = *(const u32x4*)(GB + (size_t)row * 1024 + c8);
        u32x4 ov;
#pragma unroll
        for (int j = 0; j < 4; ++j) { const int ch = c8 + 2 * j;
            const float a = bf_lo(gb[j]) * (cw[ch] * bf_lo(u2[j]) + cw[1024 + ch] * bf_lo(u1[j]) + cw[2048 + ch] * bf_lo(u0[j]));
            const float bq = bf_hi(gb[j]) * (cw[ch + 1] * bf_hi(u2[j]) + cw[1024 + ch + 1] * bf_hi(u1[j]) + cw[2048 + ch + 1] * bf_hi(u0[j]));
            ov[j] = cvtpk(a, bq); }
        *(u32x4*)(CAT + (size_t)row * DM + 1024 + c8) = ov; }
}
#define MFMA16(a, b, c) __builtin_amdgcn_mfma_f32_16x16x32_bf16((a), (b), (c), 0, 0, 0)
__device__ __forceinline__ void s5_task(const Args& a, const bf16_t* XN, const float* SS, bf16_t* Y, LAS float* S, int b, int g, int lane) {
    const float* A = (const float*)(a.ws + WS_S5A); const float* BT = (const float*)(a.ws + WS_S5B); const float* CT = (const float*)(a.ws + WS_S5C);
    const int n16 = lane & 15, j4 = lane >> 4;
    const float ar = A[(g * 64 + lane) * 2], ai = A[(g * 64 + lane) * 2 + 1];
    bf16x8 bw[8], cw[4];
#pragma unroll
    for (int ct = 0; ct < 8; ++ct) { unsigned w[4];
#pragma unroll
        for (int jj = 0; jj < 4; ++jj) { float v[2];
#pragma unroll
            for (int e = 0; e < 2; ++e) { const float x = BT[((size_t)g * 16 + 8 * (j4 & 1) + 2 * jj + e) * 128 + 8 * n16 + ct]; const float hi = __uint_as_float(cvtpk(x, 0.f) << 16); v[e] = (j4 < 2) ? x : (x - hi); }
            w[jj] = cvtpk(v[0], v[1]); }
        bw[ct] = __builtin_bit_cast(bf16x8, (u32x4){w[0], w[1], w[2], w[3]}); }
#pragma unroll
    for (int kk = 0; kk < 4; ++kk) { unsigned w[4];
#pragma unroll
        for (int jj = 0; jj < 4; ++jj) w[jj] = cvtpk(CT[((size_t)g * 128 + 32 * kk + 8 * j4 + 2 * jj) * 16 + n16], CT[((size_t)g * 128 + 32 * kk + 8 * j4 + 2 * jj + 1) * 16 + n16]);
        cw[kk] = __builtin_bit_cast(bf16x8, (u32x4){w[0], w[1], w[2], w[3]}); }
    bf16x8 dw;
    { unsigned w[4];
#pragma unroll
      for (int jj = 0; jj < 4; ++jj) { float v[2];
#pragma unroll
          for (int e = 0; e < 2; ++e) { const int c = 8 * (j4 & 1) + 2 * jj + e; const float x = (c == n16) ? a.in[18][g * 16 + n16] : 0.f; const float hi = __uint_as_float(cvtpk(x, 0.f) << 16); v[e] = (j4 < 2) ? x : (x - hi); }
          w[jj] = cvtpk(v[0], v[1]); }
      dw = __builtin_bit_cast(bf16x8, (u32x4){w[0], w[1], w[2], w[3]}); }
    float sre = 0.f, sim = 0.f;
    const size_t rowb = (size_t)b * SEQ;
    LAS unsigned short* YS = (LAS unsigned short*)(S + 16 * 132);
    u32x4 unext = *(const u32x4*)(XN + (rowb + n16) * DM + 16 * g + 8 * (j4 & 1));
    float ssn = SS[rowb + n16];
    for (int blk = 0; blk < SEQ / 16; ++blk) {
        const size_t row0 = rowb + blk * 16;
        const u32x4 uraw = unext; const float rsl = rs_of(ssn);
        { const size_t rn = (blk + 1 < SEQ / 16) ? row0 + 16 : row0;
          unext = *(const u32x4*)(XN + (rn + n16) * DM + 16 * g + 8 * (j4 & 1)); ssn = SS[rn + n16]; }
        float rsw[4];
#pragma unroll
        for (int i = 0; i < 4; ++i) rsw[i] = __shfl(rsl, 4 * j4 + i);
        const bf16x8 ua = __builtin_bit_cast(bf16x8, uraw);
        f32x4 bu[8];
#pragma unroll
        for (int ct = 0; ct < 8; ++ct) bu[ct] = MFMA16(ua, bw[ct], ((f32x4){0.f, 0.f, 0.f, 0.f}));
        const f32x4 yd = MFMA16(ua, dw, ((f32x4){0.f, 0.f, 0.f, 0.f}));
#pragma unroll
        for (int i = 0; i < 4; ++i) { LAS float* w = S + (4 * j4 + i) * 132 + 8 * n16; const float q = rsw[i];
            *(LAS f32x4*)w = (f32x4){bu[0][i] * q, bu[1][i] * q, bu[2][i] * q, bu[3][i] * q}; *(LAS f32x4*)(w + 4) = (f32x4){bu[4][i] * q, bu[5][i] * q, bu[6][i] * q, bu[7][i] * q}; }
        LDS_WAIT();
#pragma unroll
        for (int tt = 0; tt < 16; ++tt) { LAS f32x2* sp = (LAS f32x2*)(S + tt * 132 + 2 * lane); const f32x2 v = *sp;
            const float nre = ar * sre - ai * sim + v.x, nim = ar * sim + ai * sre + v.y; sre = nre; sim = nim; *sp = (f32x2){sre, sim}; }
        LDS_WAIT();
        f32x4 y = {0.f, 0.f, 0.f, 0.f};
#pragma unroll
        for (int kk = 0; kk < 4; ++kk) { const f32x4 s0 = *(LAS f32x4*)(S + n16 * 132 + 32 * kk + 8 * j4), s1 = *(LAS f32x4*)(S + n16 * 132 + 32 * kk + 8 * j4 + 4);
            const bf16x8 sa = __builtin_bit_cast(bf16x8, (u32x4){cvtpk(s0[0], s0[1]), cvtpk(s0[2], s0[3]), cvtpk(s1[0], s1[1]), cvtpk(s1[2], s1[3])});
            y = MFMA16(sa, cw[kk], y); }
#pragma unroll
        for (int i = 0; i < 4; ++i) { const float v = y[i] + yd[i] * rsw[i];
            const float ge = v * sigmoid_f(1.5957691216057308f * (v + 0.044715f * v * v * v));
            YS[(4 * j4 + i) * 16 + n16] = (unsigned short)(cvtpk(ge, 0.f) & 0xffffu); }
        LDS_WAIT();
        { const u32x2 o = *(LAS u32x2*)(YS + 4 * lane);
          *(u32x2*)(Y + (row0 + (lane >> 2)) * DM + 16 * g + 4 * (lane & 3)) = o; }
        LDS_WAIT();
    }
}

__device__ __forceinline__ void group_barrier(unsigned* ctr, unsigned nmem, unsigned& phase, bool samex) {
    asm volatile("s_waitcnt vmcnt(0)" ::: "memory");
    __syncthreads();
    ++phase;
    if (threadIdx.x == 0) {
        if (!samex) { __builtin_amdgcn_fence(__ATOMIC_RELEASE, "agent"); asm volatile("s_waitcnt vmcnt(0)" ::: "memory"); }
        __hip_atomic_fetch_add(ctr, 1u, __ATOMIC_RELAXED, __HIP_MEMORY_SCOPE_AGENT);
        const unsigned want = nmem * phase;
        while (__hip_atomic_load(ctr, __ATOMIC_RELAXED, __HIP_MEMORY_SCOPE_AGENT) < want) __builtin_amdgcn_s_sleep(2);
        __builtin_amdgcn_fence(__ATOMIC_ACQUIRE, "agent");
        asm volatile("s_waitcnt vmcnt(0)" ::: "memory");
    }
    __syncthreads();
}

#ifndef REP_UP
#define REP_UP 1
#endif
#ifndef REP_DN
#define REP_DN 1
#endif
#ifndef REP_P0
#define REP_P0 1
#endif
#ifndef REP_ATT
#define REP_ATT 1
#endif
#ifndef REP_S5
#define REP_S5 1
#endif
__global__ void __launch_bounds__(512, 2) mk_fwd(Args args) {
    extern __shared__ __attribute__((aligned(16))) unsigned char lds_raw[];
    cg::grid_group grid = cg::this_grid();
    LAS unsigned char* lds = (LAS unsigned char*)lds_raw;
    const int tid = threadIdx.x, lane = tid & 63, wave = __builtin_amdgcn_readfirstlane(tid >> 6);
    const int G = gridDim.x, gw = blockIdx.x * 8 + wave, NGW = G * 8, gtid = blockIdx.x * 512 + tid, NT = G * 512;
    const int NG = (G % 8 == 0) ? 8 : 1, grp = (NG == 8) ? (int)(blockIdx.x & 7) : 0, rk = (NG == 8) ? (int)(blockIdx.x >> 3) : (int)blockIdx.x, MEM = G / NG;
    const int gwv = rk * 8 + wave, NGWV = MEM * 8, gtv = rk * 512 + tid, NTV = MEM * 512;
    const int RPG = M_ / NG, row_g = grp * RPG;
    unsigned char* ws = args.ws; float* H = args.out;
    bf16_t* XN = (bf16_t*)(ws + WS_XN); bf16_t* BIG = (bf16_t*)(ws + WS_BIG); bf16_t* CAT = (bf16_t*)(ws + WS_CAT);
    unsigned char* slice = ws + WS_BIG + (size_t)grp * ((size_t)RPG * FF * 2); const size_t PSZ = (size_t)RPG * 1024 * 2;
    bf16_t* Qb = (bf16_t*)slice - (size_t)row_g * 1024; bf16_t* Kb = (bf16_t*)(slice + PSZ) - (size_t)row_g * 1024; bf16_t* Vb = (bf16_t*)(slice + 2 * PSZ) - (size_t)row_g * 1024;
    bf16_t* GBb = (bf16_t*)(slice + 3 * PSZ) - (size_t)row_g * 1024; bf16_t* Ub = (bf16_t*)(slice + 4 * PSZ) - (size_t)row_g * 1024;
    float* LSE = (float*)(slice + 5 * PSZ) - (size_t)row_g * 8; const size_t lse_bs = (size_t)RPG * 8;
    unsigned char* xslice = ws + WS_XN + (size_t)grp * ((size_t)RPG * DM * 2);
    bf16_t* O0 = (bf16_t*)xslice - (size_t)row_g * 1024; bf16_t* O1 = (bf16_t*)(xslice + PSZ) - (size_t)row_g * 1024;

    float* SS = (float*)(ws + WS_SS);
    unsigned* gwords = (unsigned*)(ws + WS_GRP); unsigned* gctr = gwords + 64 * grp; unsigned* gmask = gwords + 1024 + 64 * grp;
    unsigned bphase = 0; bool samex = false;
    if (blockIdx.x == 0 && tid < 16) gwords[(tid >> 3) * 1024 + 64 * (tid & 7)] = 0u;
    for (int i = gtid; i < 5 * M_; i += NT) SS[M_ + i] = 0.f;
    for (int rep = 0; rep < REP_P0; ++rep) p0_weights(args, lds, gw, NGW, wave, lane);
    p0_tables(args, gtid, NT);
    first_rows(args.in[0], H, args.in[1], XN, SS, gw, NGW, lane);
    grid.sync();
    if (NG == 8 && tid == 0) __hip_atomic_fetch_or(gmask, 1u << ((unsigned)__builtin_amdgcn_s_getreg((3 << 11) | 20) & 0xFu), __ATOMIC_RELAXED, __HIP_MEMORY_SCOPE_AGENT);
#define PBAR() do { if (NG == 1) grid.sync(); else group_barrier(gctr, (unsigned)MEM, bphase, samex); } while (0)

#define FFN(l, f, ssi, NEXT, gam, sso, hin, FIRST) do { \
    { pg8::Gemm g{XN, (const bf16_t*)(ws + WS_W13 + (size_t)((l) * 2 + (f)) * W13_SZ), M_, 2 * FF, DM}; pg8::StaticOrder S; S.init(M_, 2 * FF, G, (int)blockIdx.x); \
      pg8::EpiSwiGLU E{BIG, FF, SS + (size_t)(ssi) * M_}; pg8::gemm_phase<pg8::EpiSwiGLU, pg8::StaticOrder, true, true>(lds, g, S, E); } \
    PBAR(); \
    if (FIRST) { if (NG == 8) { const unsigned mk = __hip_atomic_load(gmask, __ATOMIC_RELAXED, __HIP_MEMORY_SCOPE_AGENT); samex = (mk & (mk - 1u)) == 0u; } } \
    { pg8::Gemm g{BIG, (const bf16_t*)(ws + WS_W2 + (size_t)((l) * 2 + (f)) * W2_SZ), M_, DM, FF}; pg8::StaticOrder S; S.init(M_, DM, G, (int)blockIdx.x, 1, 4); \
      pg8::EpiResid<NEXT> E{(hin), H, DM, 0.5f, (gam), XN, SS + (size_t)(sso) * M_}; pg8::gemm_phase<pg8::EpiResid<NEXT>, pg8::StaticOrder, true, true>(lds, g, S, E); } \
    PBAR(); } while (0)

    FFN(0, 0, 0, true, args.in[2], 1, args.in[0], true);
    { pg8::Gemm g{XN, (const bf16_t*)(ws + WS_WIN), M_, 6144, DM}; pg8::StaticOrder S; S.init(M_, 6144, G, (int)blockIdx.x);
      pg8::EpiInProj E{Qb, Kb, Vb, GBb, Ub, (const float*)(ws + WS_CS), 0.08838834764831845f * 1.4426950408889634f, SS + (size_t)1 * M_};
      pg8::gemm_phase<pg8::EpiInProj, pg8::StaticOrder, true, true>(lds, g, S, E); }
    PBAR();
    { const int tpg = 24576 / NG;
      for (int tt = gwv; tt < tpg; tt += NGWV) { const int t = grp * tpg + tt; const int b = t / 1536, rem = t - b * 1536, hd = rem / 192, rem2 = rem - hd * 192, br = rem2 >> 6, idx = rem2 & 63;
          const int lg = br == 0 ? 4 : (br == 1 ? 2 : 0), tpc = 64 >> lg, r = idx / tpc, T = idx - r * tpc;
          bf16_t* OB = br == 0 ? O0 : (br == 1 ? O1 : CAT);
          attn_task(Qb, Kb, Vb, OB, br == 2 ? DM : 1024, LSE + (size_t)br * lse_bs, lds + wave * 18432, b, hd, lg, r, T, lane); }
      PBAR();
      attn_mix_conv(O0, O1, LSE, lse_bs, Ub, GBb, args.in[9], CAT, row_g, RPG, gtv, NTV); }
    PBAR();
    { pg8::Gemm g{CAT, (const bf16_t*)(ws + WS_WOUT), M_, DM, DM}; pg8::StaticOrder S; S.init(M_, DM, G, (int)blockIdx.x, 1, 4);
      pg8::EpiResid<true> E{H, H, DM, 1.0f, args.in[3], XN, SS + (size_t)2 * M_}; pg8::gemm_phase<pg8::EpiResid<true>, pg8::StaticOrder, true, true>(lds, g, S, E); }
    PBAR();
    FFN(0, 1, 2, true, args.in[1] + DM, 3, H, false);
    FFN(1, 0, 3, true, args.in[2] + DM, 4, H, false);
    { size_t z5 = 0; asm volatile("" : "+s"(z5));
      const bf16_t* xn5 = XN + z5; bf16_t* y5 = CAT + z5; const float* ss5 = SS + (size_t)4 * M_ + z5;
      const int lane5 = (int)__builtin_amdgcn_mbcnt_hi(~0u, __builtin_amdgcn_mbcnt_lo(~0u, 0u));
      const int wpg = 2048 / NG;
      for (int w = gwv; w < wpg; w += NGWV) { const int wt = grp * wpg + w; s5_task(args, xn5, ss5, y5, (LAS float*)(lds + wave * 9216), wt >> 7, wt & 127, lane5); } }
    PBAR();
    { pg8::Gemm g{CAT, (const bf16_t*)(ws + WS_WAB), M_, 4096, DM}; pg8::StaticOrder S; S.init(M_, 4096, G, (int)blockIdx.x, 1, 2);
      pg8::EpiGLU E{H, DM, args.in[3] + DM, XN, SS + (size_t)5 * M_}; pg8::gemm_phase<pg8::EpiGLU, pg8::StaticOrder, true, true>(lds, g, S, E); }
    PBAR();
    FFN(1, 1, 5, false, args.in[4], 0, H, false);
    final_norm(H, args.in[4], row_g + gwv, row_g + RPG, NGWV, lane);
}

extern "C" void kernel_launch(void* const* d_in, const int* in_sizes, int n_in, void* d_out, int out_size, void* d_ws, size_t ws_size, hipStream_t stream) {
    static int grid = 0;
    if (grid == 0) {
        if (n_in != 21 || out_size != M_ * DM || ws_size < WS_END) { fprintf(stderr, "kernel_launch: unexpected problem (n_in %d out %d ws %zu, need %zu)\n", n_in, out_size, ws_size, (size_t)WS_END); grid = -1; return; }
        int dev = 0, cus = 0, per_cu = 0;
        hipGetDevice(&dev); hipDeviceGetAttribute(&cus, hipDeviceAttributeMultiprocessorCount, dev);
        if (hipFuncSetAttribute((const void*)mk_fwd, hipFuncAttributeMaxDynamicSharedMemorySize, LDS_BYTES) != hipSuccess) { fprintf(stderr, "kernel_launch: hipFuncSetAttribute failed\n"); grid = -1; return; }
        if (hipOccupancyMaxActiveBlocksPerMultiprocessor(&per_cu, (const void*)mk_fwd, 512, LDS_BYTES) != hipSuccess || per_cu < 1) { fprintf(stderr, "kernel_launch: occupancy query says %d\n", per_cu); per_cu = 1; (void)hipGetLastError(); }
        grid = cus * per_cu;
    }
    if (grid < 0) return;
    Args a{};
    for (int i = 0; i < 21; ++i) a.in[i] = (const float*)d_in[i];
    a.out = (float*)d_out; a.ws = (unsigned char*)d_ws;
    void* kargs[] = {&a};
    hipError_t e = hipLaunchCooperativeKernel((const void*)mk_fwd, dim3(grid), dim3(512), kargs, LDS_BYTES, stream);
    if (e != hipSuccess) fprintf(stderr, "cooperative launch failed: %s (grid %d)\n", hipGetErrorString(e), grid);
}
```

```cpp
#include <hip/hip_runtime.h>
#include <hip/hip_cooperative_groups.h>
#include <cstdio>
#include <cstdint>
namespace cg = cooperative_groups;
namespace pg8 {
#define PG8_LAS __attribute__((address_space(3)))
typedef unsigned short bf16_t;
typedef short bf16x8 __attribute__((ext_vector_type(8)));
typedef float f32x4 __attribute__((ext_vector_type(4)));
typedef unsigned u32x4 __attribute__((ext_vector_type(4)));
constexpr int BM = 256, BK = 64, HALF = 128, HTB = HALF * BK * 2  , STAGE_BYTES = 8 * HTB, NXCD = 8, WGM = 8;

__host__ __device__ __forceinline__ int lds_byte(int r, int c) { const int st = (r >> 4) * 2 + (c >> 5), rr = r & 15, cc = c & 31, ob = rr * 64 + cc * 2; return st * 1024 + (ob ^ (((ob >> 9) & 1) << 5)); }
__host__ __device__ __forceinline__ void stage_rc(int b, int& R, int& C) { const int st = b / 1024, sb = b % 1024, swz = sb ^ (((sb >> 9) & 1) << 5); R = (st >> 1) * 16 + swz / 64; C = (st & 1) * 32 + (swz % 64) / 2; }
__host__ __device__ __forceinline__ int perm32(int rho) { const int n = rho >> 4, i = rho & 15; return 8 * (i >> 2) + 4 * n + (i & 3); }

struct Unit { int pm, pn; };
struct Gemm { const bf16_t* A; const bf16_t* Bt; int M, N, K; };

struct StaticOrder {
    int nM, nN, nwg, G, c, rev, wgm;
    __host__ __device__ void init(int M, int N, int G_, int c_, int rev_ = 0, int wgm_ = WGM) { nM = M / BM; nN = N / BM; nwg = nM * nN; G = G_; c = c_; rev = (rev_ && nwg % G_ == 0) ? 1 : 0; wgm = wgm_; }
    __host__ __device__ bool next(int i, Unit& u) const {
        const int nr = nwg / G; if (rev) { if (i >= nr) return false; i = nr - 1 - i; }
        const long L = (long)i * G + c; if (L >= nwg) return false;
        int wgid = (int)L; { const int q = nwg / NXCD, r = nwg % NXCD, xcd = wgid % NXCD, off = wgid / NXCD; wgid = (xcd < r ? xcd * (q + 1) : r * (q + 1) + (xcd - r) * q) + off; }
        const int nig = wgm * nN, gid = wgid / nig, fm = gid * wgm, gsz = (nM - fm) < wgm ? (nM - fm) : wgm;
        u.pm = fm + ((wgid % nig) % gsz); u.pn = (wgid % nig) / gsz; return true;
    }
    __device__ __forceinline__ void a_ready(const Unit&) const {}
    __device__ __forceinline__ void done(const Unit&) const {}
};

__device__ __forceinline__ unsigned cvt_pk_bf16(float lo, float hi) { unsigned r; asm volatile("v_cvt_pk_bf16_f32 %0, %1, %2" : "=v"(r) : "v"(lo), "v"(hi)); return r; }
typedef unsigned u32x2 __attribute__((ext_vector_type(2)));
typedef float f32x2_t __attribute__((ext_vector_type(2))); typedef __bf16 bf16x2_t __attribute__((ext_vector_type(2)));
__device__ __forceinline__ unsigned cvtpk(float lo, float hi) { f32x2_t v = {lo, hi}; bf16x2_t b = __builtin_convertvector(v, bf16x2_t); return __builtin_bit_cast(unsigned, b); }
__device__ __forceinline__ float sigmoid_f(float x) { return __builtin_amdgcn_rcpf(1.0f + __builtin_amdgcn_exp2f(-1.4426950408889634f * x)); }
__device__ __forceinline__ float rs_of(float ss) { return __builtin_amdgcn_rsqf(ss * (1.0f / 2048.0f) + 1e-6f); }
__device__ __forceinline__ u32x4 pack8(const f32x4& a, const f32x4& b) { u32x4 w; w.x = cvtpk(a[0], a[1]); w.y = cvtpk(a[2], a[3]); w.z = cvtpk(b[0], b[1]); w.w = cvtpk(b[2], b[3]); return w; }

struct EpiSwiGLU {
    static constexpr bool PERM = true, AFTER_DRAIN = false;
    bf16_t* O; int ldc; const float* SS;
    __device__ __forceinline__ void operator()(const f32x4 (&acc)[2][2][4][2], const Unit& u, int wr, int wc, int fr, int fq) const {
        const int row0 = u.pm * BM + wr * 64 + fr, col0 = u.pn * HALF + wc * 32 + 8 * fq;
#pragma unroll
        for (int ai = 0; ai < 2; ++ai)
#pragma unroll
            for (int m = 0; m < 4; ++m) { const int row = row0 + ai * HALF + m * 16; bf16_t* rowp = O + (size_t)row * ldc + col0;
                const float rs = rs_of(SS[row]);
                f32x4 v[2];
#pragma unroll
                for (int n = 0; n < 2; ++n)
#pragma unroll
                    for (int j = 0; j < 4; ++j) { const float a = acc[ai][0][m][n][j] * rs, b = acc[ai][1][m][n][j] * rs; v[n][j] = a * sigmoid_f(a) * b; }
                *(u32x4*)rowp = pack8(v[0], v[1]); }
    }
};
template <bool NEXT> struct EpiResid {
    static constexpr bool PERM = false, AFTER_DRAIN = false;
    const float* Hin; float* H; int ldc; float scale; const float* gamma; bf16_t* XNo; float* SSo;
    __device__ __forceinline__ void operator()(const f32x4 (&acc)[2][2][4][2], const Unit& u, int wr, int wc, int fr, int fq) const {
        const int row0 = u.pm * BM + wr * 64 + fr, col0 = u.pn * BM + wc * 32 + 4 * fq;
        f32x4 gv[2][2];
        if (NEXT) {
#pragma unroll
            for (int bj = 0; bj < 2; ++bj)
#pragma unroll
                for (int n = 0; n < 2; ++n) gv[bj][n] = *(const f32x4*)(gamma + col0 + bj * HALF + n * 16); }
#pragma unroll
        for (int ai = 0; ai < 2; ++ai)
#pragma unroll
          for (int mh = 0; mh < 2; ++mh) {
            f32x4 hv[2][2][2];
#pragma unroll
            for (int m2 = 0; m2 < 2; ++m2)
#pragma unroll
                for (int bj = 0; bj < 2; ++bj)
#pragma unroll
                    for (int n = 0; n < 2; ++n) hv[m2][bj][n] = *(const f32x4*)(Hin + (size_t)(row0 + ai * HALF + (2 * mh + m2) * 16) * ldc + col0 + bj * HALF + n * 16);
#pragma unroll
            for (int m2 = 0; m2 < 2; ++m2) { const int m = 2 * mh + m2; const int row = row0 + ai * HALF + m * 16; float* rowp = H + (size_t)row * ldc + col0; float ss = 0.f;
#pragma unroll
                for (int bj = 0; bj < 2; ++bj)
#pragma unroll
                    for (int n = 0; n < 2; ++n) { const f32x4 v = hv[m2][bj][n] + scale * acc[ai][bj][m][n]; *(f32x4*)(rowp + bj * HALF + n * 16) = v;
                        if (NEXT) { ss += (v[0] * v[0] + v[1] * v[1]) + (v[2] * v[2] + v[3] * v[3]); const f32x4 w = v * gv[bj][n];
                            u32x2 o; o.x = cvtpk(w[0], w[1]); o.y = cvtpk(w[2], w[3]); *(u32x2*)(XNo + (size_t)row * ldc + col0 + bj * HALF + n * 16) = o; } }
                if (NEXT) { ss += __shfl_xor(ss, 16); ss += __shfl_xor(ss, 32); if (fq == 0) unsafeAtomicAdd(SSo + row, ss); } }
            asm volatile("" ::: "memory"); }
    }
};
struct EpiFinal {
    static constexpr bool PERM = false, AFTER_DRAIN = false;
    const float* Hin; float* Out; int ldc; float scale; const float* gamma; float* SSo; unsigned* cnt;
    __device__ __forceinline__ void operator()(const f32x4 (&acc_)[2][2][4][2], const Unit& u, int wr, int wc, int fr, int fq) const {
        f32x4 (&acc)[2][2][4][2] = const_cast<f32x4 (&)[2][2][4][2]>(acc_);
        const int row0 = u.pm * BM + wr * 64 + fr, col0 = u.pn * BM + wc * 32 + 4 * fq;
#pragma unroll
        for (int ai = 0; ai < 2; ++ai)
#pragma unroll
          for (int mh = 0; mh < 2; ++mh) {
            f32x4 hv[2][2][2];
#pragma unroll
            for (int m2 = 0; m2 < 2; ++m2)
#pragma unroll
                for (int bj = 0; bj < 2; ++bj)
#pragma unroll
                    for (int n = 0; n < 2; ++n) hv[m2][bj][n] = *(const f32x4*)(Hin + (size_t)(row0 + ai * HALF + (2 * mh + m2) * 16) * ldc + col0 + bj * HALF + n * 16);
#pragma unroll
            for (int m2 = 0; m2 < 2; ++m2) { const int m = 2 * mh + m2; const int row = row0 + ai * HALF + m * 16; float ss = 0.f;
#pragma unroll
                for (int bj = 0; bj < 2; ++bj)
#pragma unroll
                    for (int n = 0; n < 2; ++n) { const f32x4 v = hv[m2][bj][n] + scale * acc[ai][bj][m][n]; acc[ai][bj][m][n] = v; ss += (v[0] * v[0] + v[1] * v[1]) + (v[2] * v[2] + v[3] * v[3]); }
                ss += __shfl_xor(ss, 16); ss += __shfl_xor(ss, 32); if (fq == 0) unsafeAtomicAdd(SSo + row, ss); }
            asm volatile("" ::: "memory"); }
        asm volatile("s_waitcnt vmcnt(0)" ::: "memory");
        unsigned* c = cnt + 64 * u.pm;
        if (fr == 0 && fq == 0) __hip_atomic_fetch_add(c, 1u, __ATOMIC_RELAXED, __HIP_MEMORY_SCOPE_AGENT);
        while ((unsigned)__builtin_amdgcn_readfirstlane(__hip_atomic_load(c, __ATOMIC_RELAXED, __HIP_MEMORY_SCOPE_AGENT)) < 64u) __builtin_amdgcn_s_sleep(2);
        asm volatile("" ::: "memory");
        f32x4 gv[2][2];
#pragma unroll
        for (int bj = 0; bj < 2; ++bj)
#pragma unroll
            for (int n = 0; n < 2; ++n) gv[bj][n] = *(const f32x4*)(gamma + col0 + bj * HALF + n * 16);
#pragma unroll
        for (int ai = 0; ai < 2; ++ai)
#pragma unroll
            for (int m = 0; m < 4; ++m) { const int row = row0 + ai * HALF + m * 16; float* rowp = Out + (size_t)row * ldc + col0;
                const float rs = rs_of(__hip_atomic_load(SSo + row, __ATOMIC_RELAXED, __HIP_MEMORY_SCOPE_AGENT));
#pragma unroll
                for (int bj = 0; bj < 2; ++bj)
#pragma unroll
                    for (int n = 0; n < 2; ++n) *(f32x4*)(rowp + bj * HALF + n * 16) = acc[ai][bj][m][n] * rs * gv[bj][n]; }
    }
};
struct EpiGLU {
    static constexpr bool PERM = false, AFTER_DRAIN = false;
    float* H; int ldc; const float* gamma; bf16_t* XNo; float* SSo;
    __device__ __forceinline__ void operator()(const f32x4 (&acc)[2][2][4][2], const Unit& u, int wr, int wc, int fr, int fq) const {
        const int row0 = u.pm * BM + wr * 64 + fr, col0 = u.pn * HALF + wc * 32 + 4 * fq;
        f32x4 gv[2];
#pragma unroll
        for (int n = 0; n < 2; ++n) gv[n] = *(const f32x4*)(gamma + col0 + n * 16);
#pragma unroll
        for (int ai = 0; ai < 2; ++ai) {
            f32x4 hv[4][2];
#pragma unroll
            for (int m = 0; m < 4; ++m)
#pragma unroll
                for (int n = 0; n < 2; ++n) hv[m][n] = *(const f32x4*)(H + (size_t)(row0 + ai * HALF + m * 16) * ldc + col0 + n * 16);
#pragma unroll
            for (int m = 0; m < 4; ++m) { const int row = row0 + ai * HALF + m * 16; float* rowp = H + (size_t)row * ldc + col0; float ss = 0.f;
#pragma unroll
                for (int n = 0; n < 2; ++n) { f32x4 v = hv[m][n];
#pragma unroll
                    for (int j = 0; j < 4; ++j) v[j] += acc[ai][0][m][n][j] * sigmoid_f(acc[ai][1][m][n][j]);
                    *(f32x4*)(rowp + n * 16) = v; ss += (v[0] * v[0] + v[1] * v[1]) + (v[2] * v[2] + v[3] * v[3]); const f32x4 w = v * gv[n];
                    u32x2 o; o.x = cvtpk(w[0], w[1]); o.y = cvtpk(w[2], w[3]); *(u32x2*)(XNo + (size_t)row * ldc + col0 + n * 16) = o; }
                ss += __shfl_xor(ss, 16); ss += __shfl_xor(ss, 32); if (fq == 0) unsafeAtomicAdd(SSo + row, ss); }
            asm volatile("" ::: "memory"); }
    }
};
struct EpiInProj {
    static constexpr bool PERM = true, AFTER_DRAIN = false;
    bf16_t *Q, *K, *V, *GB, *U; const float* cs;
    float qscale; const float* SS;
    __device__ __forceinline__ void operator()(const f32x4 (&acc)[2][2][4][2], const Unit& u, int wr, int wc, int fr, int fq) const {
        const int row0 = u.pm * BM + wr * 64 + fr;
        if (u.pn < 8) {
            bf16_t* dst = u.pn < 4 ? Q : K; const float sc = u.pn < 4 ? qscale : 1.0f;
            const int head = 2 * (u.pn & 3) + (wc >> 1), j0 = 32 * (wc & 1) + 8 * fq;
#pragma unroll
            for (int ai = 0; ai < 2; ++ai)
#pragma unroll
                for (int m = 0; m < 4; ++m) { const int row = row0 + ai * HALF + m * 16, pos = row & 2047; const float rsc = rs_of(SS[row]) * sc;
                    const f32x4* cp = (const f32x4*)(cs + pos * 64 + j0); const f32x4* sp = (const f32x4*)(cs + 2048 * 64 + pos * 64 + j0);
                    f32x4 o1[2], o2[2];
#pragma unroll
                    for (int n = 0; n < 2; ++n) { const f32x4 c = cp[n], s = sp[n], t1 = acc[ai][0][m][n], t2 = acc[ai][1][m][n];
                        o1[n] = (t1 * c - t2 * s) * rsc; o2[n] = (t2 * c + t1 * s) * rsc; }
                    bf16_t* rowp = dst + (size_t)row * 1024 + head * 128 + j0;
                    *(u32x4*)rowp = pack8(o1[0], o1[1]); *(u32x4*)(rowp + 64) = pack8(o2[0], o2[1]);
                    asm volatile("" ::: "memory"); }
        } else if (u.pn < 16) {
            bf16_t* dst = u.pn < 12 ? V : GB; const int col0 = (u.pn & 3) * BM + wc * 32 + 8 * fq;
#pragma unroll
            for (int ai = 0; ai < 2; ++ai)
#pragma unroll
                for (int m = 0; m < 4; ++m) { const int row = row0 + ai * HALF + m * 16; bf16_t* rowp = dst + (size_t)row * 1024 + col0; const float rs = rs_of(SS[row]);
#pragma unroll
                    for (int bj = 0; bj < 2; ++bj) *(u32x4*)(rowp + bj * HALF) = pack8(acc[ai][bj][m][0] * rs, acc[ai][bj][m][1] * rs); }
        } else {
            const int col0 = (u.pn - 16) * HALF + wc * 32 + 8 * fq;
#pragma unroll
            for (int ai = 0; ai < 2; ++ai)
#pragma unroll
                for (int m = 0; m < 4; ++m) { const int row = row0 + ai * HALF + m * 16; bf16_t* rowp = U + (size_t)row * 1024 + col0; const float rs = rs_of(SS[row]), rs2 = rs * rs;
                    *(u32x4*)rowp = pack8(acc[ai][0][m][0] * acc[ai][1][m][0] * rs2, acc[ai][0][m][1] * acc[ai][1][m][1] * rs2); }
        }
    }
};
template <class Epi, class Sched, bool ALIGN_EPI = false, bool SP2 = false>
__device__ __forceinline__ void gemm_phase(PG8_LAS unsigned char* lds, const Gemm g, const Sched& S, const Epi& E) {
    const int tid = threadIdx.x, wid = __builtin_amdgcn_readfirstlane(tid >> 6), lane = tid & 63, wr = wid >> 2, wc = wid & 3, fr = lane & 15, fq = lane >> 4;
    const int K = g.K, nt = K / BK;
    unsigned voffA[2], voffB[2];
#pragma unroll
    for (int i = 0; i < 2; ++i) { int R, C; stage_rc(tid * 16 + i * 8192, R, C); const int Rb = Epi::PERM ? ((R & ~31) + perm32(R & 31)) : R;
        voffA[i] = (unsigned)(R * K + C) * 2u; voffB[i] = (unsigned)(Rb * K + C) * 2u; }
    const size_t kstep = (size_t)(BK * 2);
    const size_t hstep = (size_t)HALF * K * 2;
    const size_t tstep = 2 * hstep;
    const unsigned ldsw = (unsigned)wid * 1024u;
    const int aoff = lds_byte(wr * 64 + fr, fq * 8), boff = lds_byte(wc * 32 + fr, fq * 8);
#define PG8_SA(b, h) (((b) * 2 + (h)) * HTB)
#define PG8_SB(b, h) ((4 + (b) * 2 + (h)) * HTB)
#define PG8_STAGE(bufoff, gbase, voff) do { _Pragma("unroll") for (int _i = 0; _i < 2; ++_i) \
        __builtin_amdgcn_global_load_lds((const unsigned*)((const char*)(gbase) + (voff)[_i]), (PG8_LAS unsigned*)(lds + (bufoff) + ldsw + _i * 8192), 16, 0, 0); } while (0)
#define PG8_LDA(dst, b, h) do { _Pragma("unroll") for (int m = 0; m < 4; ++m) _Pragma("unroll") for (int k = 0; k < 2; ++k) dst[m][k] = *(const PG8_LAS bf16x8*)(lds + PG8_SA(b, h) + aoff + m * 2048 + k * 1024); } while (0)
#define PG8_LDB(dst, b, h) do { _Pragma("unroll") for (int n = 0; n < 2; ++n) _Pragma("unroll") for (int k = 0; k < 2; ++k) dst[n][k] = *(const PG8_LAS bf16x8*)(lds + PG8_SB(b, h) + boff + n * 2048 + k * 1024); } while (0)
#define PG8_MMA(ai, bj, At, Bt) do { __builtin_amdgcn_s_setprio(1); _Pragma("unroll") for (int m = 0; m < 4; ++m) _Pragma("unroll") for (int n = 0; n < 2; ++n) _Pragma("unroll") for (int k = 0; k < 2; ++k) \
        acc[ai][bj][m][n] = __builtin_amdgcn_mfma_f32_16x16x32_bf16(Bt[n][k], At[m][k], acc[ai][bj][m][n], 0, 0, 0); __builtin_amdgcn_s_setprio(0); } while (0)
#define PG8_WAIT_V(n) asm volatile("s_waitcnt vmcnt(" #n ")" ::: "memory")
#define PG8_WAIT_L(n) asm volatile("s_waitcnt lgkmcnt(" #n ")" ::: "memory")
#define PG8_BAR __builtin_amdgcn_s_barrier()
#define PG8_SCHED __builtin_amdgcn_sched_barrier(0)
    Unit cur, nxt; int ui = 0;
    if (!S.next(0, cur)) return;
    f32x4 acc[2][2][4][2];
#pragma unroll
    for (int a = 0; a < 2; ++a)
#pragma unroll
        for (int b = 0; b < 2; ++b)
#pragma unroll
            for (int m = 0; m < 4; ++m)
#pragma unroll
                for (int n = 0; n < 2; ++n) acc[a][b][m][n] = (f32x4){0.f, 0.f, 0.f, 0.f};
    bf16x8 At[4][2], B0[2][2], B1[2][2];
    const char* cA = (const char*)g.A + (size_t)cur.pm * tstep; const char* cB = (const char*)g.Bt + (size_t)cur.pn * tstep;
    S.a_ready(cur);
    if constexpr (SP2) {
        PG8_STAGE(PG8_SB(0, 0), cB, voffB); PG8_STAGE(PG8_SB(0, 1), cB + hstep, voffB); PG8_STAGE(PG8_SA(0, 0), cA, voffA); PG8_STAGE(PG8_SA(0, 1), cA + hstep, voffA);
        if (wr == 1) PG8_BAR;
        PG8_WAIT_V(2); PG8_BAR;
        PG8_STAGE(PG8_SB(1, 0), cB + kstep, voffB); PG8_STAGE(PG8_SA(1, 0), cA + kstep, voffA); PG8_STAGE(PG8_SB(1, 1), cB + hstep + kstep, voffB);
        PG8_WAIT_V(6); PG8_BAR;
    } else {
        PG8_STAGE(PG8_SB(0, 0), cB, voffB); PG8_STAGE(PG8_SA(0, 0), cA, voffA); PG8_STAGE(PG8_SB(0, 1), cB + hstep, voffB); PG8_STAGE(PG8_SA(0, 1), cA + hstep, voffA);
        if (wr == 1) PG8_BAR;
        PG8_WAIT_V(4); PG8_BAR;
        PG8_STAGE(PG8_SB(1, 0), cB + kstep, voffB); PG8_STAGE(PG8_SA(1, 0), cA + kstep, voffA); PG8_STAGE(PG8_SB(1, 1), cB + hstep + kstep, voffB);
        PG8_WAIT_V(6); PG8_BAR;
    }
    for (;;) {
        const bool has_next = S.next(ui + 1, nxt);
        const char* nA = has_next ? (const char*)g.A + (size_t)nxt.pm * tstep : cA; const char* nB = has_next ? (const char*)g.Bt + (size_t)nxt.pn * tstep : cB;
        for (int t = 0; t < nt; t += 2) {
            const bool last = (t == nt - 2);
            const char* a1 = cA + (size_t)(t + 1) * kstep;
            const char* a2 = last ? nA : cA + (size_t)(t + 2) * kstep; const char* b2 = last ? nB : cB + (size_t)(t + 2) * kstep;
            const char* a3 = a2 + kstep; const char* b3 = b2 + kstep;
            if (last && has_next) S.a_ready(nxt);
            if constexpr (SP2) {
            PG8_LDB(B0, 0, 0); PG8_LDB(B1, 0, 1); PG8_SCHED; PG8_LDA(At, 0, 0); PG8_STAGE(PG8_SA(1, 1), a1 + hstep, voffA);
            PG8_WAIT_V(8); PG8_WAIT_L(0); PG8_BAR; PG8_MMA(0, 0, At, B0); PG8_MMA(0, 1, At, B1); PG8_BAR; PG8_SCHED;
            PG8_LDA(At, 0, 1); PG8_STAGE(PG8_SB(0, 0), b2, voffB); PG8_STAGE(PG8_SB(0, 1), b2 + hstep, voffB); PG8_STAGE(PG8_SA(0, 0), a2, voffA);
            PG8_WAIT_V(8); PG8_WAIT_L(0); PG8_BAR; PG8_MMA(1, 0, At, B0); PG8_MMA(1, 1, At, B1); PG8_BAR; PG8_SCHED;
            PG8_LDB(B0, 1, 0); PG8_LDB(B1, 1, 1); PG8_SCHED; PG8_LDA(At, 1, 0); PG8_STAGE(PG8_SA(0, 1), a2 + hstep, voffA);
            PG8_WAIT_V(8); PG8_WAIT_L(0); PG8_BAR; PG8_MMA(0, 0, At, B0); PG8_MMA(0, 1, At, B1); PG8_BAR; PG8_SCHED;
            PG8_LDA(At, 1, 1); PG8_STAGE(PG8_SB(1, 0), b3, voffB); PG8_STAGE(PG8_SB(1, 1), b3 + hstep, voffB); PG8_STAGE(PG8_SA(1, 0), a3, voffA);
            PG8_WAIT_V(8); PG8_WAIT_L(0); PG8_BAR; PG8_MMA(1, 0, At, B0); PG8_MMA(1, 1, At, B1); PG8_BAR; PG8_SCHED;
            } else {
            PG8_LDB(B0, 0, 0); PG8_SCHED; PG8_LDA(At, 0, 0); PG8_STAGE(PG8_SA(1, 1), a1 + hstep, voffA);
            PG8_WAIT_L(8); PG8_BAR; PG8_WAIT_L(0); PG8_MMA(0, 0, At, B0); PG8_BAR; PG8_SCHED;
            PG8_LDB(B1, 0, 1); PG8_STAGE(PG8_SB(0, 0), b2, voffB);
            PG8_BAR; PG8_WAIT_L(0); PG8_MMA(0, 1, At, B1); PG8_BAR;
            PG8_LDA(At, 0, 1); PG8_STAGE(PG8_SA(0, 0), a2, voffA);
            PG8_BAR; PG8_WAIT_L(0); PG8_MMA(1, 0, At, B0); PG8_BAR; PG8_SCHED;
            PG8_STAGE(PG8_SB(0, 1), b2 + hstep, voffB);
            PG8_WAIT_V(6); PG8_BAR; PG8_MMA(1, 1, At, B1); PG8_BAR;
            PG8_LDB(B0, 1, 0); PG8_SCHED; PG8_LDA(At, 1, 0); PG8_STAGE(PG8_SA(0, 1), a2 + hstep, voffA);
            PG8_WAIT_L(8); PG8_BAR; PG8_WAIT_L(0); PG8_MMA(0, 0, At, B0); PG8_BAR; PG8_SCHED;
            PG8_LDB(B1, 1, 1); PG8_STAGE(PG8_SB(1, 0), b3, voffB);
            PG8_BAR; PG8_WAIT_L(0); PG8_MMA(0, 1, At, B1); PG8_BAR;
            PG8_LDA(At, 1, 1); PG8_STAGE(PG8_SA(1, 0), a3, voffA);
            PG8_BAR; PG8_WAIT_L(0); PG8_MMA(1, 0, At, B0); PG8_BAR; PG8_SCHED;
            PG8_STAGE(PG8_SB(1, 1), b3 + hstep, voffB);
            PG8_WAIT_V(6); PG8_BAR; PG8_MMA(1, 1, At, B1); PG8_BAR;
            }
        }
        if constexpr (ALIGN_EPI) { if (wr == 0) PG8_BAR; }
        if constexpr (!Epi::AFTER_DRAIN) { E(acc, cur, wr, wc, fr, fq); S.done(cur); }
        if (!has_next) break;
#pragma unroll
        for (int a = 0; a < 2; ++a)
#pragma unroll
            for (int b = 0; b < 2; ++b)
#pragma unroll
                for (int m = 0; m < 4; ++m)
#pragma unroll
                    for (int n = 0; n < 2; ++n) acc[a][b][m][n] = (f32x4){0.f, 0.f, 0.f, 0.f};
        cur = nxt; cA = nA; cB = nB; ++ui;
        if constexpr (ALIGN_EPI) { if (wr == 1) PG8_BAR; }
    }
    PG8_WAIT_V(0);
    if constexpr (!ALIGN_EPI) { if (wr == 0) PG8_BAR; }
    PG8_BAR;
    if constexpr (Epi::AFTER_DRAIN) { E.fused(acc, cur, wr, wc, fr, fq, lds, wid, lane); S.done(cur); }
#undef PG8_SA
#undef PG8_SB
#undef PG8_STAGE
#undef PG8_LDA
#undef PG8_LDB
#undef PG8_MMA
#undef PG8_WAIT_V
#undef PG8_WAIT_L
#undef PG8_BAR
#undef PG8_SCHED
}
}
#define LAS __attribute__((address_space(3)))
using pg8::bf16_t; using pg8::f32x4; using pg8::u32x4; using pg8::bf16x8; using pg8::cvtpk; using pg8::sigmoid_f; using pg8::rs_of;
typedef float f32x16 __attribute__((ext_vector_type(16)));
typedef float f32x2 __attribute__((ext_vector_type(2)));
typedef short s16x4 __attribute__((ext_vector_type(4)));
using pg8::u32x2;

constexpr int M_ = 32768, DM = 2048, FF = 5632, SEQ = 2048;
constexpr float RMS_EPS = 1e-6f;
constexpr size_t MiB = 1ull << 20;
constexpr size_t WS_CS = 0;
constexpr size_t WS_S5A = 1 * MiB;
constexpr size_t WS_GRP = 1 * MiB + 64 * 1024;
constexpr size_t WS_PCNT = 1 * MiB + 64 * 1024 + 16 * 1024;
constexpr size_t WS_SS = 1 * MiB + 128 * 1024;
constexpr size_t WS_S5B = 2 * MiB;
constexpr size_t WS_S5C = 3 * MiB;
constexpr size_t WS_W13 = 4 * MiB;  constexpr size_t W13_SZ = (size_t)2 * FF * DM * 2;
constexpr size_t WS_W2 = WS_W13 + 4 * W13_SZ;  constexpr size_t W2_SZ = (size_t)DM * FF * 2;
constexpr size_t WS_WIN = WS_W2 + 4 * W2_SZ;
constexpr size_t WS_WOUT = WS_WIN + (size_t)6144 * DM * 2;
constexpr size_t WS_WAB = WS_WOUT + (size_t)DM * DM * 2;
constexpr size_t WS_XN = WS_WAB + (size_t)4096 * DM * 2;
constexpr size_t WS_BIG = WS_XN + (size_t)M_ * DM * 2;
constexpr size_t WS_CAT = WS_BIG + (size_t)M_ * FF * 2;
constexpr size_t WS_END = WS_CAT + (size_t)M_ * DM * 2;
constexpr size_t PROJ_SZ = (size_t)M_ * 1024 * 2;
static_assert(5 * PROJ_SZ <= (size_t)M_ * FF * 2 && WS_END <= 1024 * MiB, "d_ws map");
constexpr int LDS_BYTES = 147456;

struct Args { const float* in[21]; float* out; unsigned char* ws; };

__device__ __forceinline__ float bf_lo(unsigned u) { return __uint_as_float(u << 16); }
__device__ __forceinline__ float bf_hi(unsigned u) { return __uint_as_float(u & 0xffff0000u); }
__device__ __forceinline__ float wave_sum(float v) {
#pragma unroll
    for (int o = 1; o < 64; o <<= 1) v += __shfl_xor(v, o);
    return v;
}
#define LDS_WAIT() asm volatile("s_waitcnt lgkmcnt(0)" ::: "memory")

__device__ __forceinline__ const float* src_base(const Args& a, int seg, int n0, int& ld) {
    if (seg < 4) { const int tile = n0 >> 8, within = n0 & 255, half = within >> 7, j = tile * 128 + (within & 127);
        ld = FF; return (half ? a.in[6] : a.in[5]) + (size_t)seg * DM * FF + j; }
    if (seg < 8) { ld = DM; return a.in[7] + (size_t)(seg - 4) * FF * DM + n0; }
    if (seg == 8) { ld = 6144; const int pn = n0 >> 8, within = n0 & 255, half = within >> 7, cc = within & 127; int col;
        if (pn < 8) { const int sec = pn >> 2, head = 2 * (pn & 3) + (cc >> 6), dim = (cc & 63) + 64 * half; col = sec * 1024 + head * 128 + dim; }
        else if (pn < 16) col = n0;
        else col = (half ? 5120 : 4096) + (pn - 16) * 128 + cc;
        return a.in[8] + col; }
    if (seg == 9) { ld = DM; return a.in[10] + n0; }
    { const int tile = n0 >> 8, within = n0 & 255, half = within >> 7, j = tile * 128 + (within & 127); ld = DM; return (half ? a.in[20] : a.in[19]) + j; }
}
__device__ __forceinline__ void transpose_item(const float* W, int ld, bf16_t* WT, int K, int n0, int k0, LAS float* scr, int lane) {
#pragma unroll 8
    for (int i = 0; i < 32; ++i) { const int kk = 2 * i + (lane >> 5); scr[kk * 33 + (lane & 31)] = W[(size_t)(k0 + kk) * ld + (lane & 31)]; }
    LDS_WAIT();
    const int c = lane & 7;
#pragma unroll
    for (int j = 0; j < 4; ++j) { const int n = (lane >> 3) + 8 * j; const LAS float* s = scr + (8 * c) * 33 + n;
        u32x4 o; o.x = cvtpk(s[0 * 33], s[1 * 33]); o.y = cvtpk(s[2 * 33], s[3 * 33]); o.z = cvtpk(s[4 * 33], s[5 * 33]); o.w = cvtpk(s[6 * 33], s[7 * 33]);
        *(u32x4*)(WT + (size_t)(n0 + n) * K + k0 + 8 * c) = o; }
    LDS_WAIT();
}
__device__ __forceinline__ void p0_weights(const Args& a, LAS unsigned char* lds, int gw, int NGW, int wave, int lane) {
    LAS float* scr = (LAS float*)(lds + wave * 8448);
    constexpr int I13 = (2 * FF / 32) * (DM / 64), I2 = (DM / 32) * (FF / 64), IIN = (6144 / 32) * (DM / 64), IOUT = (DM / 32) * (DM / 64), IAB = (4096 / 32) * (DM / 64);
    constexpr int TOTAL = 4 * I13 + 4 * I2 + IIN + IOUT + IAB;
    for (int it = gw; it < TOTAL; it += NGW) {
        int r = it, seg, rows, K; bf16_t* dst;
        if (r < 4 * I13) { seg = r / I13; r -= seg * I13; rows = 2 * FF; K = DM; dst = (bf16_t*)(a.ws + WS_W13 + (size_t)seg * W13_SZ); }
        else { r -= 4 * I13;
            if (r < 4 * I2) { const int i = r / I2; r -= i * I2; seg = 4 + i; rows = DM; K = FF; dst = (bf16_t*)(a.ws + WS_W2 + (size_t)i * W2_SZ); }
            else { r -= 4 * I2;
                if (r < IIN) { seg = 8; rows = 6144; K = DM; dst = (bf16_t*)(a.ws + WS_WIN); }
                else { r -= IIN;
                    if (r < IOUT) { seg = 9; rows = DM; K = DM; dst = (bf16_t*)(a.ws + WS_WOUT); }
                    else { r -= IOUT; seg = 10; rows = 4096; K = DM; dst = (bf16_t*)(a.ws + WS_WAB); } } } }
        const int nblk = rows / 32, nb = r % nblk, kb = r / nblk; int ld;
        const float* W = src_base(a, seg, nb * 32, ld);
        transpose_item(W, ld, dst, K, nb * 32, kb * 64, scr, lane);
    }
}
__device__ __forceinline__ void p0_tables(const Args& a, int gtid, int NT) {
    float* cs = (float*)(a.ws + WS_CS);
    for (int i = gtid; i < SEQ * 64; i += NT) { const int pos = i >> 6, j = i & 63;
        const float inv = (float)pow(10000.0, -(double)j / 64.0); const float ang = (float)pos * inv;
        cs[i] = (float)cos((double)ang); cs[SEQ * 64 + i] = (float)sin((double)ang); }
    float* A = (float*)(a.ws + WS_S5A); float* BT = (float*)(a.ws + WS_S5B); float* CT = (float*)(a.ws + WS_S5C);
    for (int i = gtid; i < 128 * 64; i += NT) { const int g = i >> 6, p = i & 63;
        const double lr = a.in[11][i], li = a.in[12][i], dt = exp((double)a.in[13][g]);
        const double mag = exp(lr * dt), ar = mag * cos(li * dt), ai = mag * sin(li * dt), den = lr * lr + li * li;
        const double fr = ((ar - 1.0) * lr + ai * li) / den, fi = (ai * lr - (ar - 1.0) * li) / den;
        A[2 * i] = (float)ar; A[2 * i + 1] = (float)ai;
        for (int c = 0; c < 16; ++c) { const double br = a.in[14][(size_t)i * 16 + c], bi = a.in[15][(size_t)i * 16 + c];
            BT[((size_t)g * 16 + c) * 128 + 2 * p] = (float)(fr * br - fi * bi); BT[((size_t)g * 16 + c) * 128 + 2 * p + 1] = (float)(fr * bi + fi * br);
            CT[((size_t)g * 128 + 2 * p) * 16 + c] = a.in[16][((size_t)g * 16 + c) * 64 + p]; CT[((size_t)g * 128 + 2 * p + 1) * 16 + c] = -a.in[17][((size_t)g * 16 + c) * 64 + p]; }
    }
}
__device__ __forceinline__ void first_rows(const float* src, float* cpy, const float* gamma, bf16_t* xn, float* ss0, int gw, int NGW, int lane) {
    for (int m = gw; m < M_; m += NGW) {
        const f32x4* xr = (const f32x4*)(src + (size_t)m * DM) + lane; f32x4 v[8]; float s = 0.f;
#pragma unroll
        for (int j = 0; j < 8; ++j) { v[j] = xr[64 * j]; s += (v[j].x * v[j].x + v[j].y * v[j].y) + (v[j].z * v[j].z + v[j].w * v[j].w); }
        s = wave_sum(s); if (lane == 0) ss0[m] = s;
        const f32x4* gr = (const f32x4*)gamma + lane; u32x2* o = (u32x2*)(xn + (size_t)m * DM) + lane;
#pragma unroll
        for (int j = 0; j < 8; ++j) { const f32x4 g = gr[64 * j]; u32x2 w; w.x = cvtpk(v[j].x * g.x, v[j].y * g.y); w.y = cvtpk(v[j].z * g.z, v[j].w * g.w); o[64 * j] = w; }
    }
}
__device__ __forceinline__ void final_norm(float* h, const float* gamma, int m_begin, int m_end, int step, int lane) {
    for (int m = m_begin; m < m_end; m += step) {
        f32x4* xr = (f32x4*)(h + (size_t)m * DM) + lane; f32x4 v[8]; float s = 0.f;
#pragma unroll
        for (int j = 0; j < 8; ++j) { v[j] = xr[64 * j]; s += (v[j].x * v[j].x + v[j].y * v[j].y) + (v[j].z * v[j].z + v[j].w * v[j].w); }
        const float rs = 1.0f / sqrtf(wave_sum(s) * (1.0f / DM) + RMS_EPS);
        const f32x4* gr = (const f32x4*)gamma + lane;
#pragma unroll
        for (int j = 0; j < 8; ++j) xr[64 * j] = v[j] * rs * gr[64 * j];
    }
}
#define MFMA32(a, b, c) __builtin_amdgcn_mfma_f32_32x32x16_bf16((a), (b), (c), 0, 0, 0)
typedef short v4i16_t __attribute__((ext_vector_type(4)));
__device__ __forceinline__ s16x4 vtr(unsigned byte_addr) { return __builtin_bit_cast(s16x4, __builtin_amdgcn_ds_read_tr16_b64_v4i16((LAS v4i16_t*)(size_t)byte_addr)); }
__device__ __forceinline__ void attn_task(const bf16_t* Q, const bf16_t* Kb, const bf16_t* Vb, bf16_t* OB, int ostride, float* LSE, LAS unsigned char* vl, int b, int hd, int lg, int r, int T, int lane) {
    const int qi = lane & 31, h = lane >> 5, lr = lane >> 4, lp = lane & 15;
    const int cq = 32 * T + qi;
    const size_t qrow = (size_t)b * SEQ + (cq << lg) + r;
    const int ckbase = 32 * T - 128;
    int c = ckbase < 0 ? (-ckbase) >> 5 : 0;
#define ATT_ROWPTR(P, ck, it) ((P) + ((size_t)b * SEQ + (((ck) + 4 * (it) + lr) << lg) + r) * 1024 + hd * 128 + 8 * lp)
    u32x4 kr[8], vr[8];
#pragma unroll
    for (int it = 0; it < 8; ++it) kr[it] = *(const u32x4*)ATT_ROWPTR(Q, 32 * T, it);
#pragma unroll
    for (int it = 0; it < 8; ++it) *(LAS u32x4*)(vl + (4 * it + lr) * 272 + 16 * lp) = kr[it];
#pragma unroll
    for (int it = 0; it < 8; ++it) kr[it] = *(const u32x4*)ATT_ROWPTR(Kb, ckbase + 32 * c, it);
#pragma unroll
    for (int it = 0; it < 8; ++it) vr[it] = *(const u32x4*)ATT_ROWPTR(Vb, ckbase + 32 * c, it);
    LDS_WAIT();
#pragma unroll
    for (int ks = 0; ks < 8; ++ks) *(LAS bf16x8*)(vl + 10240 + (ks * 64 + lane) * 16) = *(LAS bf16x8*)(vl + qi * 272 + 32 * ks + 16 * h);
    LDS_WAIT();
    f32x16 o[4];
#pragma unroll
    for (int dc = 0; dc < 4; ++dc)
#pragma unroll
        for (int i = 0; i < 16; ++i) o[dc][i] = 0.f;
    float m_run = -1e30f, l_run = 0.f;
    const int i16 = lane & 15, tq = i16 >> 2, tp = i16 & 3, blk = (lane >> 4) & 1;
    const unsigned vbase = (unsigned)(size_t)vl;
    const unsigned tr_off = vbase + (unsigned)((4 * h + tq) * 320 + 2 * (16 * blk + 4 * tp));
    for (;;) {
        const bool has_next = c < 4;
        const int ck0 = ckbase + 32 * c;
#pragma unroll
        for (int it = 0; it < 8; ++it) *(LAS u32x4*)(vl + (4 * it + lr) * 272 + 16 * lp) = kr[it];
        if (has_next) {
#pragma unroll
            for (int it = 0; it < 8; ++it) kr[it] = *(const u32x4*)ATT_ROWPTR(Kb, ck0 + 32, it); }
        LDS_WAIT();
        f32x16 s;
#pragma unroll
        for (int i = 0; i < 16; ++i) s[i] = 0.f;
#pragma unroll
        for (int ks = 0; ks < 8; ++ks) s = MFMA32(*(LAS bf16x8*)(vl + qi * 272 + 32 * ks + 16 * h), *(LAS bf16x8*)(vl + 10240 + (ks * 64 + lane) * 16), s);
        LDS_WAIT();
#pragma unroll
        for (int it = 0; it < 8; ++it) *(LAS u32x4*)(vl + (4 * it + lr) * 320 + 16 * lp) = vr[it];
        if (has_next) {
#pragma unroll
            for (int it = 0; it < 8; ++it) vr[it] = *(const u32x4*)ATT_ROWPTR(Vb, ck0 + 32, it); }
        float mx = -1e30f;
        if (c == 0 || c == 4) {
#pragma unroll
            for (int i = 0; i < 16; ++i) { const int ck = ck0 + (i & 3) + 8 * (i >> 2) + 4 * h; const bool ok = (ck <= cq) && (ck >= cq - 128); s[i] = ok ? s[i] : -1e30f; } }
#pragma unroll
        for (int i = 0; i < 16; ++i) mx = fmaxf(mx, s[i]);
        mx = fmaxf(mx, __shfl_xor(mx, 32));
        const float m_new = fmaxf(m_run, mx), alpha = __builtin_amdgcn_exp2f(m_run - m_new);
        float ps = 0.f;
#pragma unroll
        for (int i = 0; i < 16; ++i) { const float p = (s[i] > -1e29f) ? __builtin_amdgcn_exp2f(s[i] - m_new) : 0.f; s[i] = p; ps += p; }
        l_run = l_run * alpha + ps; m_run = m_new;
#pragma unroll
        for (int dc = 0; dc < 4; ++dc)
#pragma unroll
            for (int i = 0; i < 16; ++i) o[dc][i] *= alpha;
        bf16x8 pf[2];
#pragma unroll
        for (int s2 = 0; s2 < 2; ++s2) { u32x4 w; w.x = cvtpk(s[8 * s2 + 0], s[8 * s2 + 1]); w.y = cvtpk(s[8 * s2 + 2], s[8 * s2 + 3]); w.z = cvtpk(s[8 * s2 + 4], s[8 * s2 + 5]); w.w = cvtpk(s[8 * s2 + 6], s[8 * s2 + 7]); pf[s2] = __builtin_bit_cast(bf16x8, w); }
        LDS_WAIT();
#pragma unroll
        for (int dc = 0; dc < 4; ++dc)
#pragma unroll
            for (int s2 = 0; s2 < 2; ++s2) {
                const s16x4 lo = vtr(tr_off + (unsigned)(16 * s2 * 320 + 64 * dc)), hi = vtr(tr_off + (unsigned)((16 * s2 + 8) * 320 + 64 * dc));
                const bf16x8 va = __builtin_shufflevector(lo, hi, 0, 1, 2, 3, 4, 5, 6, 7);
                o[dc] = MFMA32(va, pf[s2], o[dc]); }
        LDS_WAIT();
        if (!has_next) break;
        ++c;
    }
#undef ATT_ROWPTR
    const float l = l_run + __shfl_xor(l_run, 32), inv = 1.0f / l;
    if (h == 0) LSE[qrow * 8 + hd] = m_run + __builtin_amdgcn_logf(l);
    bf16_t* op = OB + qrow * ostride + hd * 128 + 4 * h;
#pragma unroll
    for (int dc = 0; dc < 4; ++dc)
#pragma unroll
        for (int g = 0; g < 4; ++g) { u32x2 w; w.x = cvtpk(o[dc][4 * g] * inv, o[dc][4 * g + 1] * inv); w.y = cvtpk(o[dc][4 * g + 2] * inv, o[dc][4 * g + 3] * inv);
            *(u32x2*)(op + 32 * dc + 8 * g) = w; }
}
__device__ __forceinline__ void attn_mix_conv(const bf16_t* O0, const bf16_t* O1, const float* LSE, size_t lse_bs, const bf16_t* U, const bf16_t* GB, const float* cw, bf16_t* CAT, int row_begin, int nrows, int gtid, int NT) {
    for (int idx = gtid; idx < nrows * 128; idx += NT) { const int row = row_begin + (idx >> 7), c8 = (idx & 127) * 8, pos = row & (SEQ - 1), hd = c8 >> 7;
        { const float l0 = LSE[(size_t)row * 8 + hd], l1 = LSE[lse_bs + (size_t)row * 8 + hd], l2 = LSE[2 * lse_bs + (size_t)row * 8 + hd];
          const float mm = fmaxf(l0, fmaxf(l1, l2)); float w0 = __builtin_amdgcn_exp2f(l0 - mm), w1 = __builtin_amdgcn_exp2f(l1 - mm), w2 = __builtin_amdgcn_exp2f(l2 - mm);
          const float iw = 1.0f / (w0 + w1 + w2); w0 *= iw; w1 *= iw; w2 *= iw;
          const u32x4 a0 = *(const u32x4*)(O0 + (size_t)row * 1024 + c8), a1 = *(const u32x4*)(O1 + (size_t)row * 1024 + c8), a2 = *(const u32x4*)(CAT + (size_t)row * DM + c8);
          u32x4 ov;
#pragma unroll
          for (int j = 0; j < 4; ++j) ov[j] = cvtpk(w0 * bf_lo(a0[j]) + w1 * bf_lo(a1[j]) + w2 * bf_lo(a2[j]), w0 * bf_hi(a0[j]) + w1 * bf_hi(a1[j]) + w2 * bf_hi(a2[j]));
          *(u32x4*)(CAT + (size_t)row * DM + c8) = ov; }
        const u32x4 z = {0u, 0u, 0u, 0u};
        const u32x4 u0 = *(const u32x4*)(U + (size_t)row * 1024 + c8), u1 = pos >= 1 ? *(const u32x4*)(U + (size_t)(row - 1) * 1024 + c8) : z, u2 = pos >= 2 ? *(const u32x4*)(U + (size_t)(row - 2) * 1024 + c8) : z;
        const u32x4 gb = *(const u32x4*)(GB + (size_t)row * 1024 + c8);
        u32x4 ov;
#pragma unroll
        for (int j = 0; j < 4; ++j) { const int ch = c8 + 2 * j;
            const float a = bf_lo(gb[j]) * (cw[ch] * bf_lo(u2[j]) + cw[1024 + ch] * bf_lo(u1[j]) + cw[2048 + ch] * bf_lo(u0[j]));
            const float bq = bf_hi(gb[j]) * (cw[ch + 1] * bf_hi(u2[j]) + cw[1024 + ch + 1] * bf_hi(u1[j]) + cw[2048 + ch + 1] * bf_hi(u0[j]));
            ov[j] = cvtpk(a, bq); }
        *(u32x4*)(CAT + (size_t)row * DM + 1024 + c8) = ov; }
}
#define MFMA16(a, b, c) __builtin_amdgcn_mfma_f32_16x16x32_bf16((a), (b), (c), 0, 0, 0)
__device__ __forceinline__ void s5_task(const Args& a, const bf16_t* XN, const float* SS, bf16_t* Y, LAS float* S, int b, int g, int lane) {
    const float* A = (const float*)(a.ws + WS_S5A); const float* BT = (const float*)(a.ws + WS_S5B); const float* CT = (const float*)(a.ws + WS_S5C);
    const int n16 = lane & 15, j4 = lane >> 4;
    const float ar = A[(g * 64 + lane) * 2], ai = A[(g * 64 + lane) * 2 + 1];
    bf16x8 bw[8], cw[4];
#pragma unroll
    for (int ct = 0; ct < 8; ++ct) { unsigned w[4];
#pragma unroll
        for (int jj = 0; jj < 4; ++jj) { float v[2];
#pragma unroll
            for (int e = 0; e < 2; ++e) { const float x = BT[((size_t)g * 16 + 8 * (j4 & 1) + 2 * jj + e) * 128 + 8 * n16 + ct]; const float hi = __uint_as_float(cvtpk(x, 0.f) << 16); v[e] = (j4 < 2) ? x : (x - hi); }
            w[jj] = cvtpk(v[0], v[1]); }
        bw[ct] = __builtin_bit_cast(bf16x8, (u32x4){w[0], w[1], w[2], w[3]}); }
#pragma unroll
    for (int kk = 0; kk < 4; ++kk) { unsigned w[4];
#pragma unroll
        for (int jj = 0; jj < 4; ++jj) w[jj] = cvtpk(CT[((size_t)g * 128 + 32 * kk + 8 * j4 + 2 * jj) * 16 + n16], CT[((size_t)g * 128 + 32 * kk + 8 * j4 + 2 * jj + 1) * 16 + n16]);
        cw[kk] = __builtin_bit_cast(bf16x8, (u32x4){w[0], w[1], w[2], w[3]}); }
    bf16x8 dw;
    { unsigned w[4];
#pragma unroll
      for (int jj = 0; jj < 4; ++jj) { float v[2];
#pragma unroll
          for (int e = 0; e < 2; ++e) { const int c = 8 * (j4 & 1) + 2 * jj + e; const float x = (c == n16) ? a.in[18][g * 16 + n16] : 0.f; const float hi = __uint_as_float(cvtpk(x, 0.f) << 16); v[e] = (j4 < 2) ? x : (x - hi); }
          w[jj] = cvtpk(v[0], v[1]); }
      dw = __builtin_bit_cast(bf16x8, (u32x4){w[0], w[1], w[2], w[3]}); }
    float sre = 0.f, sim = 0.f;
    const size_t rowb = (size_t)b * SEQ;
    LAS unsigned short* YS = (LAS unsigned short*)(S + 16 * 132);
    u32x4 unext = *(const u32x4*)(XN + (rowb + n16) * DM + 16 * g + 8 * (j4 & 1));
    float ssn = SS[rowb + n16];
    for (int blk = 0; blk < SEQ / 16; ++blk) {
        const size_t row0 = rowb + blk * 16;
        const u32x4 uraw = unext; const float rsl = rs_of(ssn);
        { const size_t rn = (blk + 1 < SEQ / 16) ? row0 + 16 : row0;
          unext = *(const u32x4*)(XN + (rn + n16) * DM + 16 * g + 8 * (j4 & 1)); ssn = SS[rn + n16]; }
        float rsw[4];
#pragma unroll
        for (int i = 0; i < 4; ++i) rsw[i] = __shfl(rsl, 4 * j4 + i);
        const bf16x8 ua = __builtin_bit_cast(bf16x8, uraw);
        f32x4 bu[8];
#pragma unroll
        for (int ct = 0; ct < 8; ++ct) bu[ct] = MFMA16(ua, bw[ct], ((f32x4){0.f, 0.f, 0.f, 0.f}));
        const f32x4 yd = MFMA16(ua, dw, ((f32x4){0.f, 0.f, 0.f, 0.f}));
#pragma unroll
        for (int i = 0; i < 4; ++i) { LAS float* w = S + (4 * j4 + i) * 132 + 8 * n16; const float q = rsw[i];
            *(LAS f32x4*)w = (f32x4){bu[0][i] * q, bu[1][i] * q, bu[2][i] * q, bu[3][i] * q}; *(LAS f32x4*)(w + 4) = (f32x4){bu[4][i] * q, bu[5][i] * q, bu[6][i] * q, bu[7][i] * q}; }
        LDS_WAIT();
#pragma unroll
        for (int tt = 0; tt < 16; ++tt) { LAS f32x2* sp = (LAS f32x2*)(S + tt * 132 + 2 * lane); const f32x2 v = *sp;
            const float nre = ar * sre - ai * sim + v.x, nim = ar * sim + ai * sre + v.y; sre = nre; sim = nim; *sp = (f32x2){sre, sim}; }
        LDS_WAIT();
        f32x4 y = {0.f, 0.f, 0.f, 0.f};
#pragma unroll
        for (int kk = 0; kk < 4; ++kk) { const f32x4 s0 = *(LAS f32x4*)(S + n16 * 132 + 32 * kk + 8 * j4), s1 = *(LAS f32x4*)(S + n16 * 132 + 32 * kk + 8 * j4 + 4);
            const bf16x8 sa = __builtin_bit_cast(bf16x8, (u32x4){cvtpk(s0[0], s0[1]), cvtpk(s0[2], s0[3]), cvtpk(s1[0], s1[1]), cvtpk(s1[2], s1[3])});
            y = MFMA16(sa, cw[kk], y); }
#pragma unroll
        for (int i = 0; i < 4; ++i) { const float v = y[i] + yd[i] * rsw[i];
            const float ge = v * sigmoid_f(1.5957691216057308f * (v + 0.044715f * v * v * v));
            YS[(4 * j4 + i) * 16 + n16] = (unsigned short)(cvtpk(ge, 0.f) & 0xffffu); }
        LDS_WAIT();
        { const u32x2 o = *(LAS u32x2*)(YS + 4 * lane);
          *(u32x2*)(Y + (row0 + (lane >> 2)) * DM + 16 * g + 4 * (lane & 3)) = o; }
        LDS_WAIT();
    }
}

__device__ __forceinline__ void group_barrier(unsigned* ctr, unsigned nmem, unsigned& phase, bool samex) {
    asm volatile("s_waitcnt vmcnt(0)" ::: "memory");
    __syncthreads();
    ++phase;
    if (threadIdx.x == 0) {
        if (!samex) { __builtin_amdgcn_fence(__ATOMIC_RELEASE, "agent"); asm volatile("s_waitcnt vmcnt(0)" ::: "memory"); }
        __hip_atomic_fetch_add(ctr, 1u, __ATOMIC_RELAXED, __HIP_MEMORY_SCOPE_AGENT);
        const unsigned want = nmem * phase;
        while (__hip_atomic_load(ctr, __ATOMIC_RELAXED, __HIP_MEMORY_SCOPE_AGENT) < want) __builtin_amdgcn_s_sleep(2);
        __builtin_amdgcn_fence(__ATOMIC_ACQUIRE, "agent");
        asm volatile("s_waitcnt vmcnt(0)" ::: "memory");
    }
    __syncthreads();
}

#ifndef REP_UP
#define REP_UP 1
#endif
#ifndef REP_DN
#define REP_DN 1
#endif
#ifndef REP_P0
#define REP_P0 1
#endif
#ifndef REP_ATT
#define REP_ATT 1
#endif
#ifndef REP_S5
#define REP_S5 1
#endif
__global__ void __launch_bounds__(512, 2) mk_fwd(Args args) {
    extern __shared__ __attribute__((aligned(16))) unsigned char lds_raw[];
    cg::grid_group grid = cg::this_grid();
    LAS unsigned char* lds = (LAS unsigned char*)lds_raw;
    const int tid = threadIdx.x, lane = tid & 63, wave = __builtin_amdgcn_readfirstlane(tid >> 6);
    const int G = gridDim.x, gw = blockIdx.x * 8 + wave, NGW = G * 8, gtid = blockIdx.x * 512 + tid, NT = G * 512;
    const int NG = (G % 8 == 0) ? 8 : 1, grp = (NG == 8) ? (int)(blockIdx.x & 7) : 0, rk = (NG == 8) ? (int)(blockIdx.x >> 3) : (int)blockIdx.x, MEM = G / NG;
    const int gwv = rk * 8 + wave, NGWV = MEM * 8, gtv = rk * 512 + tid, NTV = MEM * 512;
    const int RPG = M_ / NG, row_g = grp * RPG;
    unsigned char* ws = args.ws; float* H = args.out;
    bf16_t* XN = (bf16_t*)(ws + WS_XN); bf16_t* BIG = (bf16_t*)(ws + WS_BIG); bf16_t* CAT = (bf16_t*)(ws + WS_CAT);
    unsigned char* slice = ws + WS_BIG + (size_t)grp * ((size_t)RPG * FF * 2); const size_t PSZ = (size_t)RPG * 1024 * 2;
    bf16_t* Qb = (bf16_t*)slice - (size_t)row_g * 1024; bf16_t* Kb = (bf16_t*)(slice + PSZ) - (size_t)row_g * 1024; bf16_t* Vb = (bf16_t*)(slice + 2 * PSZ) - (size_t)row_g * 1024;
    bf16_t* GBb = (bf16_t*)(slice + 3 * PSZ) - (size_t)row_g * 1024; bf16_t* Ub = (bf16_t*)(slice + 4 * PSZ) - (size_t)row_g * 1024;
    float* LSE = (float*)(slice + 5 * PSZ) - (size_t)row_g * 8; const size_t lse_bs = (size_t)RPG * 8;
    unsigned char* xslice = ws + WS_XN + (size_t)grp * ((size_t)RPG * DM * 2);
    bf16_t* O0 = (bf16_t*)xslice - (size_t)row_g * 1024; bf16_t* O1 = (bf16_t*)(xslice + PSZ) - (size_t)row_g * 1024;

    float* SS = (float*)(ws + WS_SS);
    unsigned* gwords = (unsigned*)(ws + WS_GRP); unsigned* gctr = gwords + 64 * grp; unsigned* gmask = gwords + 1024 + 64 * grp;
    unsigned bphase = 0; bool samex = false;
    if (blockIdx.x == 0 && tid < 16) gwords[(tid >> 3) * 1024 + 64 * (tid & 7)] = 0u;
    for (int i = gtid; i < 6 * M_; i += NT) SS[M_ + i] = 0.f;
    for (int i = gtid; i < 128 * 64; i += NT) ((unsigned*)(ws + WS_PCNT))[i] = 0u;
    for (int rep = 0; rep < REP_P0; ++rep) p0_weights(args, lds, gw, NGW, wave, lane);
    p0_tables(args, gtid, NT);
    first_rows(args.in[0], H, args.in[1], XN, SS, gw, NGW, lane);
    grid.sync();
    if (NG == 8 && tid == 0) __hip_atomic_fetch_or(gmask, 1u << ((unsigned)__builtin_amdgcn_s_getreg((3 << 11) | 20) & 0xFu), __ATOMIC_RELAXED, __HIP_MEMORY_SCOPE_AGENT);
#define PBAR() do { if (NG == 1) grid.sync(); else group_barrier(gctr, (unsigned)MEM, bphase, samex); } while (0)

#define FFN(l, f, ssi, NEXT, gam, sso, hin, FIRST) do { \
    { pg8::Gemm g{XN, (const bf16_t*)(ws + WS_W13 + (size_t)((l) * 2 + (f)) * W13_SZ), M_, 2 * FF, DM}; pg8::StaticOrder S; S.init(M_, 2 * FF, G, (int)blockIdx.x); \
      pg8::EpiSwiGLU E{BIG, FF, SS + (size_t)(ssi) * M_}; pg8::gemm_phase<pg8::EpiSwiGLU, pg8::StaticOrder, true, true>(lds, g, S, E); } \
    PBAR(); \
    if (FIRST) { if (NG == 8) { const unsigned mk = __hip_atomic_load(gmask, __ATOMIC_RELAXED, __HIP_MEMORY_SCOPE_AGENT); samex = (mk & (mk - 1u)) == 0u; } } \
    { pg8::Gemm g{BIG, (const bf16_t*)(ws + WS_W2 + (size_t)((l) * 2 + (f)) * W2_SZ), M_, DM, FF}; pg8::StaticOrder S; S.init(M_, DM, G, (int)blockIdx.x, 1, 4); \
      pg8::EpiResid<NEXT> E{(hin), H, DM, 0.5f, (gam), XN, SS + (size_t)(sso) * M_}; pg8::gemm_phase<pg8::EpiResid<NEXT>, pg8::StaticOrder, true, true>(lds, g, S, E); } \
    PBAR(); } while (0)

    FFN(0, 0, 0, true, args.in[2], 1, args.in[0], true);
    { pg8::Gemm g{XN, (const bf16_t*)(ws + WS_WIN), M_, 6144, DM}; pg8::StaticOrder S; S.init(M_, 6144, G, (int)blockIdx.x);
      pg8::EpiInProj E{Qb, Kb, Vb, GBb, Ub, (const float*)(ws + WS_CS), 0.08838834764831845f * 1.4426950408889634f, SS + (size_t)1 * M_};
      pg8::gemm_phase<pg8::EpiInProj, pg8::StaticOrder, true, true>(lds, g, S, E); }
    PBAR();
    { const int tpg = 24576 / NG;
      for (int tt = gwv; tt < tpg; tt += NGWV) { const int t = grp * tpg + tt; const int b = t / 1536, rem = t - b * 1536, hd = rem / 192, rem2 = rem - hd * 192, br = rem2 >> 6, idx = rem2 & 63;
          const int lg = br == 0 ? 4 : (br == 1 ? 2 : 0), tpc = 64 >> lg, r = idx / tpc, T = idx - r * tpc;
          bf16_t* OB = br == 0 ? O0 : (br == 1 ? O1 : CAT);
          attn_task(Qb, Kb, Vb, OB, br == 2 ? DM : 1024, LSE + (size_t)br * lse_bs, lds + wave * 18432, b, hd, lg, r, T, lane); }
      PBAR();
      attn_mix_conv(O0, O1, LSE, lse_bs, Ub, GBb, args.in[9], CAT, row_g, RPG, gtv, NTV); }
    PBAR();
    { pg8::Gemm g{CAT, (const bf16_t*)(ws + WS_WOUT), M_, DM, DM}; pg8::StaticOrder S; S.init(M_, DM, G, (int)blockIdx.x, 1, 4);
      pg8::EpiResid<true> E{H, H, DM, 1.0f, args.in[3], XN, SS + (size_t)2 * M_}; pg8::gemm_phase<pg8::EpiResid<true>, pg8::StaticOrder, true, true>(lds, g, S, E); }
    PBAR();
    FFN(0, 1, 2, true, args.in[1] + DM, 3, H, false);
    FFN(1, 0, 3, true, args.in[2] + DM, 4, H, false);
    { size_t z5 = 0; asm volatile("" : "+s"(z5));
      const bf16_t* xn5 = XN + z5; bf16_t* y5 = CAT + z5; const float* ss5 = SS + (size_t)4 * M_ + z5;
      const int lane5 = (int)__builtin_amdgcn_mbcnt_hi(~0u, __builtin_amdgcn_mbcnt_lo(~0u, 0u));
      const int wpg = 2048 / NG;
      for (int w = gwv; w < wpg; w += NGWV) { const int wt = grp * wpg + w; s5_task(args, xn5, ss5, y5, (LAS float*)(lds + wave * 9216), wt >> 7, wt & 127, lane5); } }
    PBAR();
    { pg8::Gemm g{CAT, (const bf16_t*)(ws + WS_WAB), M_, 4096, DM}; pg8::StaticOrder S; S.init(M_, 4096, G, (int)blockIdx.x, 1, 2);
      pg8::EpiGLU E{H, DM, args.in[3] + DM, XN, SS + (size_t)5 * M_}; pg8::gemm_phase<pg8::EpiGLU, pg8::StaticOrder, true, true>(lds, g, S, E); }
    PBAR();
    if (G == 256) {
        { pg8::Gemm g{XN, (const bf16_t*)(ws + WS_W13 + (size_t)3 * W13_SZ), M_, 2 * FF, DM}; pg8::StaticOrder S; S.init(M_, 2 * FF, G, (int)blockIdx.x);
          pg8::EpiSwiGLU E{BIG, FF, SS + (size_t)5 * M_}; pg8::gemm_phase<pg8::EpiSwiGLU, pg8::StaticOrder, true, true>(lds, g, S, E); }
        PBAR();
        { pg8::Gemm g{BIG, (const bf16_t*)(ws + WS_W2 + (size_t)3 * W2_SZ), M_, DM, FF}; pg8::StaticOrder S; S.init(M_, DM, G, (int)blockIdx.x, 1, 4);
          pg8::EpiFinal E{H, H, DM, 0.5f, args.in[4], SS + (size_t)6 * M_, (unsigned*)(ws + WS_PCNT)}; pg8::gemm_phase<pg8::EpiFinal, pg8::StaticOrder, true, true>(lds, g, S, E); }
    } else {
        FFN(1, 1, 5, false, args.in[4], 0, H, false);
        final_norm(H, args.in[4], row_g + gwv, row_g + RPG, NGWV, lane);
    }
}

extern "C" void kernel_launch(void* const* d_in, const int* in_sizes, int n_in, void* d_out, int out_size, void* d_ws, size_t ws_size, hipStream_t stream) {
    static int grid = 0;
    if (grid == 0) {
        if (n_in != 21 || out_size != M_ * DM || ws_size < WS_END) { fprintf(stderr, "kernel_launch: unexpected problem (n_in %d out %d ws %zu, need %zu)\n", n_in, out_size, ws_size, (size_t)WS_END); grid = -1; return; }
        int dev = 0, cus = 0, per_cu = 0;
        hipGetDevice(&dev); hipDeviceGetAttribute(&cus, hipDeviceAttributeMultiprocessorCount, dev);
        if (hipFuncSetAttribute((const void*)mk_fwd, hipFuncAttributeMaxDynamicSharedMemorySize, LDS_BYTES) != hipSuccess) { fprintf(stderr, "kernel_launch: hipFuncSetAttribute failed\n"); grid = -1; return; }
        if (hipOccupancyMaxActiveBlocksPerMultiprocessor(&per_cu, (const void*)mk_fwd, 512, LDS_BYTES) != hipSuccess || per_cu < 1) { fprintf(stderr, "kernel_launch: occupancy query says %d\n", per_cu); per_cu = 1; (void)hipGetLastError(); }
        grid = cus * per_cu;
    }
    if (grid < 0) return;
    Args a{};
    for (int i = 0; i < 21; ++i) a.in[i] = (const float*)d_in[i];
    a.out = (float*)d_out; a.ws = (unsigned char*)d_ws;
    void* kargs[] = {&a};
    hipError_t e = hipLaunchCooperativeKernel((const void*)mk_fwd, dim3(grid), dim3(512), kargs, LDS_BYTES, stream);
    if (e != hipSuccess) fprintf(stderr, "cooperative launch failed: %s (grid %d)\n", hipGetErrorString(e), grid);
}
```

```cpp
#include <hip/hip_runtime.h>
#include <hip/hip_cooperative_groups.h>
#include <cstdio>
#include <cstdint>
namespace cg = cooperative_groups;
namespace pg8 {
#define PG8_LAS __attribute__((address_space(3)))
typedef unsigned short bf16_t;
typedef short bf16x8 __attribute__((ext_vector_type(8)));
typedef float f32x4 __attribute__((ext_vector_type(4)));
typedef unsigned u32x4 __attribute__((ext_vector_type(4)));
constexpr int BM = 256, BK = 64, HALF = 128, HTB = HALF * BK * 2  , STAGE_BYTES = 8 * HTB, NXCD = 8, WGM = 8;

__host__ __device__ __forceinline__ int lds_byte(int r, int c) { const int st = (r >> 4) * 2 + (c >> 5), rr = r & 15, cc = c & 31, ob = rr * 64 + cc * 2; return st * 1024 + (ob ^ (((ob >> 9) & 1) << 5)); }
__host__ __device__ __forceinline__ void stage_rc(int b, int& R, int& C) { const int st = b / 1024, sb = b % 1024, swz = sb ^ (((sb >> 9) & 1) << 5); R = (st >> 1) * 16 + swz / 64; C = (st & 1) * 32 + (swz % 64) / 2; }
__host__ __device__ __forceinline__ int perm32(int rho) { const int n = rho >> 4, i = rho & 15; return 8 * (i >> 2) + 4 * n + (i & 3); }

struct Unit { int pm, pn; };
struct Gemm { const bf16_t* A; const bf16_t* Bt; int M, N, K; };

struct StaticOrder {
    int nM, nN, nwg, G, c, rev, wgm;
    __host__ __device__ void init(int M, int N, int G_, int c_, int rev_ = 0, int wgm_ = WGM) { nM = M / BM; nN = N / BM; nwg = nM * nN; G = G_; c = c_; rev = (rev_ && nwg % G_ == 0) ? 1 : 0; wgm = wgm_; }
    __host__ __device__ bool next(int i, Unit& u) const {
        const int nr = nwg / G; if (rev) { if (i >= nr) return false; i = nr - 1 - i; }
        const long L = (long)i * G + c; if (L >= nwg) return false;
        int wgid = (int)L; { const int q = nwg / NXCD, r = nwg % NXCD, xcd = wgid % NXCD, off = wgid / NXCD; wgid = (xcd < r ? xcd * (q + 1) : r * (q + 1) + (xcd - r) * q) + off; }
        const int nig = wgm * nN, gid = wgid / nig, fm = gid * wgm, gsz = (nM - fm) < wgm ? (nM - fm) : wgm;
        u.pm = fm + ((wgid % nig) % gsz); u.pn = (wgid % nig) / gsz; return true;
    }
    __device__ __forceinline__ void a_ready(const Unit&) const {}
    __device__ __forceinline__ void done(const Unit&) const {}
};

__device__ __forceinline__ unsigned cvt_pk_bf16(float lo, float hi) { unsigned r; asm volatile("v_cvt_pk_bf16_f32 %0, %1, %2" : "=v"(r) : "v"(lo), "v"(hi)); return r; }
typedef unsigned u32x2 __attribute__((ext_vector_type(2)));
typedef float f32x2_t __attribute__((ext_vector_type(2))); typedef __bf16 bf16x2_t __attribute__((ext_vector_type(2)));
__device__ __forceinline__ unsigned cvtpk(float lo, float hi) { f32x2_t v = {lo, hi}; bf16x2_t b = __builtin_convertvector(v, bf16x2_t); return __builtin_bit_cast(unsigned, b); }
__device__ __forceinline__ float sigmoid_f(float x) { return __builtin_amdgcn_rcpf(1.0f + __builtin_amdgcn_exp2f(-1.4426950408889634f * x)); }
__device__ __forceinline__ float rs_of(float ss) { return __builtin_amdgcn_rsqf(ss * (1.0f / 2048.0f) + 1e-6f); }
__device__ __forceinline__ u32x4 pack8(const f32x4& a, const f32x4& b) { u32x4 w; w.x = cvtpk(a[0], a[1]); w.y = cvtpk(a[2], a[3]); w.z = cvtpk(b[0], b[1]); w.w = cvtpk(b[2], b[3]); return w; }

struct EpiSwiGLU {
    static constexpr bool PERM = true, AFTER_DRAIN = false;
    bf16_t* O; int ldc; const float* SS;
    PG8_LAS float* rsc; mutable int last_pm;
    __device__ __forceinline__ void operator()(const f32x4 (&acc)[2][2][4][2], const Unit& u, int wr, int wc, int fr, int fq) const {
        const int row0 = u.pm * BM + wr * 64 + fr, col0 = u.pn * HALF + wc * 32 + 8 * fq;
        const int slot = (int)threadIdx.x;
        if (u.pm != last_pm) { last_pm = u.pm;
#pragma unroll
            for (int am = 0; am < 8; ++am) rsc[am * 512 + slot] = rs_of(SS[row0 + (am >> 2) * HALF + (am & 3) * 16]); }
#pragma unroll
        for (int ai = 0; ai < 2; ++ai)
#pragma unroll
            for (int m = 0; m < 4; ++m) { const int row = row0 + ai * HALF + m * 16; bf16_t* rowp = O + (size_t)row * ldc + col0;
                const float rs = rsc[(ai * 4 + m) * 512 + slot];
                f32x4 v[2];
#pragma unroll
                for (int n = 0; n < 2; ++n)
#pragma unroll
                    for (int j = 0; j < 4; ++j) { const float a = acc[ai][0][m][n][j] * rs, b = acc[ai][1][m][n][j] * rs; v[n][j] = a * sigmoid_f(a) * b; }
                *(u32x4*)rowp = pack8(v[0], v[1]); }
    }
};
template <bool NEXT> struct EpiResid {
    static constexpr bool PERM = false, AFTER_DRAIN = false;
    const float* Hin; float* H; int ldc; float scale; const float* gamma; bf16_t* XNo; float* SSo;
    __device__ __forceinline__ void operator()(const f32x4 (&acc)[2][2][4][2], const Unit& u, int wr, int wc, int fr, int fq) const {
        const int row0 = u.pm * BM + wr * 64 + fr, col0 = u.pn * BM + wc * 32 + 4 * fq;
        f32x4 gv[2][2];
        if (NEXT) {
#pragma unroll
            for (int bj = 0; bj < 2; ++bj)
#pragma unroll
                for (int n = 0; n < 2; ++n) gv[bj][n] = *(const f32x4*)(gamma + col0 + bj * HALF + n * 16); }
#pragma unroll
        for (int ai = 0; ai < 2; ++ai)
#pragma unroll
          for (int mh = 0; mh < 2; ++mh) {
            f32x4 hv[2][2][2];
#pragma unroll
            for (int m2 = 0; m2 < 2; ++m2)
#pragma unroll
                for (int bj = 0; bj < 2; ++bj)
#pragma unroll
                    for (int n = 0; n < 2; ++n) hv[m2][bj][n] = *(const f32x4*)(Hin + (size_t)(row0 + ai * HALF + (2 * mh + m2) * 16) * ldc + col0 + bj * HALF + n * 16);
#pragma unroll
            for (int m2 = 0; m2 < 2; ++m2) { const int m = 2 * mh + m2; const int row = row0 + ai * HALF + m * 16; float* rowp = H + (size_t)row * ldc + col0; float ss = 0.f;
#pragma unroll
                for (int bj = 0; bj < 2; ++bj)
#pragma unroll
                    for (int n = 0; n < 2; ++n) { const f32x4 v = hv[m2][bj][n] + scale * acc[ai][bj][m][n]; *(f32x4*)(rowp + bj * HALF + n * 16) = v;
                        if (NEXT) { ss += (v[0] * v[0] + v[1] * v[1]) + (v[2] * v[2] + v[3] * v[3]); const f32x4 w = v * gv[bj][n];
                            u32x2 o; o.x = cvtpk(w[0], w[1]); o.y = cvtpk(w[2], w[3]); *(u32x2*)(XNo + (size_t)row * ldc + col0 + bj * HALF + n * 16) = o; } }
                if (NEXT) { ss += __shfl_xor(ss, 16); ss += __shfl_xor(ss, 32); if (fq == 0) unsafeAtomicAdd(SSo + row, ss); } }
            asm volatile("" ::: "memory"); }
    }
};
struct EpiFinal {
    static constexpr bool PERM = false, AFTER_DRAIN = false;
    const float* Hin; float* Out; int ldc; float scale; const float* gamma; float* SSo; unsigned* cnt;
    __device__ __forceinline__ void operator()(const f32x4 (&acc_)[2][2][4][2], const Unit& u, int wr, int wc, int fr, int fq) const {
        f32x4 (&acc)[2][2][4][2] = const_cast<f32x4 (&)[2][2][4][2]>(acc_);
        const int row0 = u.pm * BM + wr * 64 + fr, col0 = u.pn * BM + wc * 32 + 4 * fq;
#pragma unroll
        for (int ai = 0; ai < 2; ++ai)
#pragma unroll
          for (int mh = 0; mh < 2; ++mh) {
            f32x4 hv[2][2][2];
#pragma unroll
            for (int m2 = 0; m2 < 2; ++m2)
#pragma unroll
                for (int bj = 0; bj < 2; ++bj)
#pragma unroll
                    for (int n = 0; n < 2; ++n) hv[m2][bj][n] = *(const f32x4*)(Hin + (size_t)(row0 + ai * HALF + (2 * mh + m2) * 16) * ldc + col0 + bj * HALF + n * 16);
#pragma unroll
            for (int m2 = 0; m2 < 2; ++m2) { const int m = 2 * mh + m2; const int row = row0 + ai * HALF + m * 16; float ss = 0.f;
#pragma unroll
                for (int bj = 0; bj < 2; ++bj)
#pragma unroll
                    for (int n = 0; n < 2; ++n) { const f32x4 v = hv[m2][bj][n] + scale * acc[ai][bj][m][n]; acc[ai][bj][m][n] = v; ss += (v[0] * v[0] + v[1] * v[1]) + (v[2] * v[2] + v[3] * v[3]); }
                ss += __shfl_xor(ss, 16); ss += __shfl_xor(ss, 32); if (fq == 0) unsafeAtomicAdd(SSo + row, ss); }
            asm volatile("" ::: "memory"); }
        asm volatile("s_waitcnt vmcnt(0)" ::: "memory");
        unsigned* c = cnt + 64 * u.pm;
        if (fr == 0 && fq == 0) __hip_atomic_fetch_add(c, 1u, __ATOMIC_RELAXED, __HIP_MEMORY_SCOPE_AGENT);
        while ((unsigned)__builtin_amdgcn_readfirstlane(__hip_atomic_load(c, __ATOMIC_RELAXED, __HIP_MEMORY_SCOPE_AGENT)) < 64u) __builtin_amdgcn_s_sleep(2);
        asm volatile("" ::: "memory");
        f32x4 gv[2][2];
#pragma unroll
        for (int bj = 0; bj < 2; ++bj)
#pragma unroll
            for (int n = 0; n < 2; ++n) gv[bj][n] = *(const f32x4*)(gamma + col0 + bj * HALF + n * 16);
#pragma unroll
        for (int ai = 0; ai < 2; ++ai)
#pragma unroll
            for (int m = 0; m < 4; ++m) { const int row = row0 + ai * HALF + m * 16; float* rowp = Out + (size_t)row * ldc + col0;
                const float rs = rs_of(__hip_atomic_load(SSo + row, __ATOMIC_RELAXED, __HIP_MEMORY_SCOPE_AGENT));
#pragma unroll
                for (int bj = 0; bj < 2; ++bj)
#pragma unroll
                    for (int n = 0; n < 2; ++n) *(f32x4*)(rowp + bj * HALF + n * 16) = acc[ai][bj][m][n] * rs * gv[bj][n]; }
    }
};
struct EpiGLU {
    static constexpr bool PERM = false, AFTER_DRAIN = false;
    float* H; int ldc; const float* gamma; bf16_t* XNo; float* SSo;
    __device__ __forceinline__ void operator()(const f32x4 (&acc)[2][2][4][2], const Unit& u, int wr, int wc, int fr, int fq) const {
        const int row0 = u.pm * BM + wr * 64 + fr, col0 = u.pn * HALF + wc * 32 + 4 * fq;
        f32x4 gv[2];
#pragma unroll
        for (int n = 0; n < 2; ++n) gv[n] = *(const f32x4*)(gamma + col0 + n * 16);
#pragma unroll
        for (int ai = 0; ai < 2; ++ai) {
            f32x4 hv[4][2];
#pragma unroll
            for (int m = 0; m < 4; ++m)
#pragma unroll
                for (int n = 0; n < 2; ++n) hv[m][n] = *(const f32x4*)(H + (size_t)(row0 + ai * HALF + m * 16) * ldc + col0 + n * 16);
#pragma unroll
            for (int m = 0; m < 4; ++m) { const int row = row0 + ai * HALF + m * 16; float* rowp = H + (size_t)row * ldc + col0; float ss = 0.f;
#pragma unroll
                for (int n = 0; n < 2; ++n) { f32x4 v = hv[m][n];
#pragma unroll
                    for (int j = 0; j < 4; ++j) v[j] += acc[ai][0][m][n][j] * sigmoid_f(acc[ai][1][m][n][j]);
                    *(f32x4*)(rowp + n * 16) = v; ss += (v[0] * v[0] + v[1] * v[1]) + (v[2] * v[2] + v[3] * v[3]); const f32x4 w = v * gv[n];
                    u32x2 o; o.x = cvtpk(w[0], w[1]); o.y = cvtpk(w[2], w[3]); *(u32x2*)(XNo + (size_t)row * ldc + col0 + n * 16) = o; }
                ss += __shfl_xor(ss, 16); ss += __shfl_xor(ss, 32); if (fq == 0) unsafeAtomicAdd(SSo + row, ss); }
            asm volatile("" ::: "memory"); }
    }
};
struct EpiInProj {
    static constexpr bool PERM = true, AFTER_DRAIN = false;
    bf16_t *Q, *K, *V, *GB, *U; const float* cs;
    float qscale; const float* SS;
    __device__ __forceinline__ void operator()(const f32x4 (&acc)[2][2][4][2], const Unit& u, int wr, int wc, int fr, int fq) const {
        const int row0 = u.pm * BM + wr * 64 + fr;
        if (u.pn < 8) {
            bf16_t* dst = u.pn < 4 ? Q : K; const float sc = u.pn < 4 ? qscale : 1.0f;
            const int head = 2 * (u.pn & 3) + (wc >> 1), j0 = 32 * (wc & 1) + 8 * fq;
#pragma unroll
            for (int ai = 0; ai < 2; ++ai)
#pragma unroll
                for (int m = 0; m < 4; ++m) { const int row = row0 + ai * HALF + m * 16, pos = row & 2047; const float rsc = rs_of(SS[row]) * sc;
                    const f32x4* cp = (const f32x4*)(cs + pos * 64 + j0); const f32x4* sp = (const f32x4*)(cs + 2048 * 64 + pos * 64 + j0);
                    f32x4 o1[2], o2[2];
#pragma unroll
                    for (int n = 0; n < 2; ++n) { const f32x4 c = cp[n], s = sp[n], t1 = acc[ai][0][m][n], t2 = acc[ai][1][m][n];
                        o1[n] = (t1 * c - t2 * s) * rsc; o2[n] = (t2 * c + t1 * s) * rsc; }
                    bf16_t* rowp = dst + (size_t)row * 1024 + head * 128 + j0;
                    *(u32x4*)rowp = pack8(o1[0], o1[1]); *(u32x4*)(rowp + 64) = pack8(o2[0], o2[1]);
                    asm volatile("" ::: "memory"); }
        } else if (u.pn < 16) {
            bf16_t* dst = u.pn < 12 ? V : GB; const int col0 = (u.pn & 3) * BM + wc * 32 + 8 * fq;
#pragma unroll
            for (int ai = 0; ai < 2; ++ai)
#pragma unroll
                for (int m = 0; m < 4; ++m) { const int row = row0 + ai * HALF + m * 16; bf16_t* rowp = dst + (size_t)row * 1024 + col0; const float rs = rs_of(SS[row]);
#pragma unroll
                    for (int bj = 0; bj < 2; ++bj) *(u32x4*)(rowp + bj * HALF) = pack8(acc[ai][bj][m][0] * rs, acc[ai][bj][m][1] * rs); }
        } else {
            const int col0 = (u.pn - 16) * HALF + wc * 32 + 8 * fq;
#pragma unroll
            for (int ai = 0; ai < 2; ++ai)
#pragma unroll
                for (int m = 0; m < 4; ++m) { const int row = row0 + ai * HALF + m * 16; bf16_t* rowp = U + (size_t)row * 1024 + col0; const float rs = rs_of(SS[row]), rs2 = rs * rs;
                    *(u32x4*)rowp = pack8(acc[ai][0][m][0] * acc[ai][1][m][0] * rs2, acc[ai][0][m][1] * acc[ai][1][m][1] * rs2); }
        }
    }
};
template <class Epi, class Sched, bool ALIGN_EPI = false, bool SP2 = false>
__device__ __forceinline__ void gemm_phase(PG8_LAS unsigned char* lds, const Gemm g, const Sched& S, const Epi& E) {
    const int tid = threadIdx.x, wid = __builtin_amdgcn_readfirstlane(tid >> 6), lane = tid & 63, wr = wid >> 2, wc = wid & 3, fr = lane & 15, fq = lane >> 4;
    const int K = g.K, nt = K / BK;
    unsigned voffA[2], voffB[2];
#pragma unroll
    for (int i = 0; i < 2; ++i) { int R, C; stage_rc(tid * 16 + i * 8192, R, C); const int Rb = Epi::PERM ? ((R & ~31) + perm32(R & 31)) : R;
        voffA[i] = (unsigned)(R * K + C) * 2u; voffB[i] = (unsigned)(Rb * K + C) * 2u; }
    const size_t kstep = (size_t)(BK * 2);
    const size_t hstep = (size_t)HALF * K * 2;
    const size_t tstep = 2 * hstep;
    const unsigned ldsw = (unsigned)wid * 1024u;
    const int aoff = lds_byte(wr * 64 + fr, fq * 8), boff = lds_byte(wc * 32 + fr, fq * 8);
#define PG8_SA(b, h) (((b) * 2 + (h)) * HTB)
#define PG8_SB(b, h) ((4 + (b) * 2 + (h)) * HTB)
#define PG8_STAGE(bufoff, gbase, voff) do { _Pragma("unroll") for (int _i = 0; _i < 2; ++_i) \
        __builtin_amdgcn_global_load_lds((const unsigned*)((const char*)(gbase) + (voff)[_i]), (PG8_LAS unsigned*)(lds + (bufoff) + ldsw + _i * 8192), 16, 0, 0); } while (0)
#define PG8_LDA(dst, b, h) do { _Pragma("unroll") for (int m = 0; m < 4; ++m) _Pragma("unroll") for (int k = 0; k < 2; ++k) dst[m][k] = *(const PG8_LAS bf16x8*)(lds + PG8_SA(b, h) + aoff + m * 2048 + k * 1024); } while (0)
#define PG8_LDB(dst, b, h) do { _Pragma("unroll") for (int n = 0; n < 2; ++n) _Pragma("unroll") for (int k = 0; k < 2; ++k) dst[n][k] = *(const PG8_LAS bf16x8*)(lds + PG8_SB(b, h) + boff + n * 2048 + k * 1024); } while (0)
#define PG8_MMA(ai, bj, At, Bt) do { __builtin_amdgcn_s_setprio(1); _Pragma("unroll") for (int m = 0; m < 4; ++m) _Pragma("unroll") for (int n = 0; n < 2; ++n) _Pragma("unroll") for (int k = 0; k < 2; ++k) \
        acc[ai][bj][m][n] = __builtin_amdgcn_mfma_f32_16x16x32_bf16(Bt[n][k], At[m][k], acc[ai][bj][m][n], 0, 0, 0); __builtin_amdgcn_s_setprio(0); } while (0)
#define PG8_WAIT_V(n) asm volatile("s_waitcnt vmcnt(" #n ")" ::: "memory")
#define PG8_WAIT_L(n) asm volatile("s_waitcnt lgkmcnt(" #n ")" ::: "memory")
#define PG8_BAR __builtin_amdgcn_s_barrier()
#define PG8_SCHED __builtin_amdgcn_sched_barrier(0)
    Unit cur, nxt; int ui = 0;
    if (!S.next(0, cur)) return;
    f32x4 acc[2][2][4][2];
#pragma unroll
    for (int a = 0; a < 2; ++a)
#pragma unroll
        for (int b = 0; b < 2; ++b)
#pragma unroll
            for (int m = 0; m < 4; ++m)
#pragma unroll
                for (int n = 0; n < 2; ++n) acc[a][b][m][n] = (f32x4){0.f, 0.f, 0.f, 0.f};
    bf16x8 At[4][2], B0[2][2], B1[2][2];
    const char* cA = (const char*)g.A + (size_t)cur.pm * tstep; const char* cB = (const char*)g.Bt + (size_t)cur.pn * tstep;
    S.a_ready(cur);
    if constexpr (SP2) {
        PG8_STAGE(PG8_SB(0, 0), cB, voffB); PG8_STAGE(PG8_SB(0, 1), cB + hstep, voffB); PG8_STAGE(PG8_SA(0, 0), cA, voffA); PG8_STAGE(PG8_SA(0, 1), cA + hstep, voffA);
        if (wr == 1) PG8_BAR;
        PG8_WAIT_V(2); PG8_BAR;
        PG8_STAGE(PG8_SB(1, 0), cB + kstep, voffB); PG8_STAGE(PG8_SA(1, 0), cA + kstep, voffA); PG8_STAGE(PG8_SB(1, 1), cB + hstep + kstep, voffB);
        PG8_WAIT_V(6); PG8_BAR;
    } else {
        PG8_STAGE(PG8_SB(0, 0), cB, voffB); PG8_STAGE(PG8_SA(0, 0), cA, voffA); PG8_STAGE(PG8_SB(0, 1), cB + hstep, voffB); PG8_STAGE(PG8_SA(0, 1), cA + hstep, voffA);
        if (wr == 1) PG8_BAR;
        PG8_WAIT_V(4); PG8_BAR;
        PG8_STAGE(PG8_SB(1, 0), cB + kstep, voffB); PG8_STAGE(PG8_SA(1, 0), cA + kstep, voffA); PG8_STAGE(PG8_SB(1, 1), cB + hstep + kstep, voffB);
        PG8_WAIT_V(6); PG8_BAR;
    }
    for (;;) {
        const bool has_next = S.next(ui + 1, nxt);
        const char* nA = has_next ? (const char*)g.A + (size_t)nxt.pm * tstep : cA; const char* nB = has_next ? (const char*)g.Bt + (size_t)nxt.pn * tstep : cB;
        for (int t = 0; t < nt; t += 2) {
            const bool last = (t == nt - 2);
            const char* a1 = cA + (size_t)(t + 1) * kstep;
            const char* a2 = last ? nA : cA + (size_t)(t + 2) * kstep; const char* b2 = last ? nB : cB + (size_t)(t + 2) * kstep;
            const char* a3 = a2 + kstep; const char* b3 = b2 + kstep;
            if (last && has_next) S.a_ready(nxt);
            if constexpr (SP2) {
            PG8_LDB(B0, 0, 0); PG8_LDB(B1, 0, 1); PG8_SCHED; PG8_LDA(At, 0, 0); PG8_STAGE(PG8_SA(1, 1), a1 + hstep, voffA);
            PG8_WAIT_V(8); PG8_WAIT_L(0); PG8_BAR; PG8_MMA(0, 0, At, B0); PG8_MMA(0, 1, At, B1); PG8_BAR; PG8_SCHED;
            PG8_LDA(At, 0, 1); PG8_STAGE(PG8_SB(0, 0), b2, voffB); PG8_STAGE(PG8_SB(0, 1), b2 + hstep, voffB); PG8_STAGE(PG8_SA(0, 0), a2, voffA);
            PG8_WAIT_V(8); PG8_WAIT_L(0); PG8_BAR; PG8_MMA(1, 0, At, B0); PG8_MMA(1, 1, At, B1); PG8_BAR; PG8_SCHED;
            PG8_LDB(B0, 1, 0); PG8_LDB(B1, 1, 1); PG8_SCHED; PG8_LDA(At, 1, 0); PG8_STAGE(PG8_SA(0, 1), a2 + hstep, voffA);
            PG8_WAIT_V(8); PG8_WAIT_L(0); PG8_BAR; PG8_MMA(0, 0, At, B0); PG8_MMA(0, 1, At, B1); PG8_BAR; PG8_SCHED;
            PG8_LDA(At, 1, 1); PG8_STAGE(PG8_SB(1, 0), b3, voffB); PG8_STAGE(PG8_SB(1, 1), b3 + hstep, voffB); PG8_STAGE(PG8_SA(1, 0), a3, voffA);
            PG8_WAIT_V(8); PG8_WAIT_L(0); PG8_BAR; PG8_MMA(1, 0, At, B0); PG8_MMA(1, 1, At, B1); PG8_BAR; PG8_SCHED;
            } else {
            PG8_LDB(B0, 0, 0); PG8_SCHED; PG8_LDA(At, 0, 0); PG8_STAGE(PG8_SA(1, 1), a1 + hstep, voffA);
            PG8_WAIT_L(8); PG8_BAR; PG8_WAIT_L(0); PG8_MMA(0, 0, At, B0); PG8_BAR; PG8_SCHED;
            PG8_LDB(B1, 0, 1); PG8_STAGE(PG8_SB(0, 0), b2, voffB);
            PG8_BAR; PG8_WAIT_L(0); PG8_MMA(0, 1, At, B1); PG8_BAR;
            PG8_LDA(At, 0, 1); PG8_STAGE(PG8_SA(0, 0), a2, voffA);
            PG8_BAR; PG8_WAIT_L(0); PG8_MMA(1, 0, At, B0); PG8_BAR; PG8_SCHED;
            PG8_STAGE(PG8_SB(0, 1), b2 + hstep, voffB);
            PG8_WAIT_V(6); PG8_BAR; PG8_MMA(1, 1, At, B1); PG8_BAR;
            PG8_LDB(B0, 1, 0); PG8_SCHED; PG8_LDA(At, 1, 0); PG8_STAGE(PG8_SA(0, 1), a2 + hstep, voffA);
            PG8_WAIT_L(8); PG8_BAR; PG8_WAIT_L(0); PG8_MMA(0, 0, At, B0); PG8_BAR; PG8_SCHED;
            PG8_LDB(B1, 1, 1); PG8_STAGE(PG8_SB(1, 0), b3, voffB);
            PG8_BAR; PG8_WAIT_L(0); PG8_MMA(0, 1, At, B1); PG8_BAR;
            PG8_LDA(At, 1, 1); PG8_STAGE(PG8_SA(1, 0), a3, voffA);
            PG8_BAR; PG8_WAIT_L(0); PG8_MMA(1, 0, At, B0); PG8_BAR; PG8_SCHED;
            PG8_STAGE(PG8_SB(1, 1), b3 + hstep, voffB);
            PG8_WAIT_V(6); PG8_BAR; PG8_MMA(1, 1, At, B1); PG8_BAR;
            }
        }
        if constexpr (ALIGN_EPI) { if (wr == 0) PG8_BAR; }
        if constexpr (!Epi::AFTER_DRAIN) { E(acc, cur, wr, wc, fr, fq); S.done(cur); }
        if (!has_next) break;
#pragma unroll
        for (int a = 0; a < 2; ++a)
#pragma unroll
            for (int b = 0; b < 2; ++b)
#pragma unroll
                for (int m = 0; m < 4; ++m)
#pragma unroll
                    for (int n = 0; n < 2; ++n) acc[a][b][m][n] = (f32x4){0.f, 0.f, 0.f, 0.f};
        cur = nxt; cA = nA; cB = nB; ++ui;
        if constexpr (ALIGN_EPI) { if (wr == 1) PG8_BAR; }
    }
    PG8_WAIT_V(0);
    if constexpr (!ALIGN_EPI) { if (wr == 0) PG8_BAR; }
    PG8_BAR;
    if constexpr (Epi::AFTER_DRAIN) { E.fused(acc, cur, wr, wc, fr, fq, lds, wid, lane); S.done(cur); }
#undef PG8_SA
#undef PG8_SB
#undef PG8_STAGE
#undef PG8_LDA
#undef PG8_LDB
#undef PG8_MMA
#undef PG8_WAIT_V
#undef PG8_WAIT_L
#undef PG8_BAR
#undef PG8_SCHED
}
}
#define LAS __attribute__((address_space(3)))
using pg8::bf16_t; using pg8::f32x4; using pg8::u32x4; using pg8::bf16x8; using pg8::cvtpk; using pg8::sigmoid_f; using pg8::rs_of;
typedef float f32x16 __attribute__((ext_vector_type(16)));
typedef float f32x2 __attribute__((ext_vector_type(2)));
typedef short s16x4 __attribute__((ext_vector_type(4)));
using pg8::u32x2;

constexpr int M_ = 32768, DM = 2048, FF = 5632, SEQ = 2048;
constexpr float RMS_EPS = 1e-6f;
constexpr size_t MiB = 1ull << 20;
constexpr size_t WS_CS = 0;
constexpr size_t WS_S5A = 1 * MiB;
constexpr size_t WS_GRP = 1 * MiB + 64 * 1024;
constexpr size_t WS_PCNT = 1 * MiB + 64 * 1024 + 16 * 1024;
constexpr size_t WS_SS = 1 * MiB + 128 * 1024;
constexpr size_t WS_S5B = 2 * MiB;
constexpr size_t WS_S5C = 3 * MiB;
constexpr size_t WS_W13 = 4 * MiB;  constexpr size_t W13_SZ = (size_t)2 * FF * DM * 2;
constexpr size_t WS_W2 = WS_W13 + 4 * W13_SZ;  constexpr size_t W2_SZ = (size_t)DM * FF * 2;
constexpr size_t WS_WIN = WS_W2 + 4 * W2_SZ;
constexpr size_t WS_WOUT = WS_WIN + (size_t)6144 * DM * 2;
constexpr size_t WS_WAB = WS_WOUT + (size_t)DM * DM * 2;
constexpr size_t WS_XN = WS_WAB + (size_t)4096 * DM * 2;
constexpr size_t WS_BIG = WS_XN + (size_t)M_ * DM * 2;
constexpr size_t WS_CAT = WS_BIG + (size_t)M_ * FF * 2;
constexpr size_t WS_END = WS_CAT + (size_t)M_ * DM * 2;
constexpr size_t PROJ_SZ = (size_t)M_ * 1024 * 2;
static_assert(5 * PROJ_SZ <= (size_t)M_ * FF * 2 && WS_END <= 1024 * MiB, "d_ws map");
constexpr int LDS_BYTES = 147456;

struct Args { const float* in[21]; float* out; unsigned char* ws; };

__device__ __forceinline__ float bf_lo(unsigned u) { return __uint_as_float(u << 16); }
__device__ __forceinline__ float bf_hi(unsigned u) { return __uint_as_float(u & 0xffff0000u); }
__device__ __forceinline__ float wave_sum(float v) {
#pragma unroll
    for (int o = 1; o < 64; o <<= 1) v += __shfl_xor(v, o);
    return v;
}
#define LDS_WAIT() asm volatile("s_waitcnt lgkmcnt(0)" ::: "memory")

__device__ __forceinline__ const float* src_base(const Args& a, int seg, int n0, int& ld) {
    if (seg < 4) { const int tile = n0 >> 8, within = n0 & 255, half = within >> 7, j = tile * 128 + (within & 127);
        ld = FF; return (half ? a.in[6] : a.in[5]) + (size_t)seg * DM * FF + j; }
    if (seg < 8) { ld = DM; return a.in[7] + (size_t)(seg - 4) * FF * DM + n0; }
    if (seg == 8) { ld = 6144; const int pn = n0 >> 8, within = n0 & 255, half = within >> 7, cc = within & 127; int col;
        if (pn < 8) { const int sec = pn >> 2, head = 2 * (pn & 3) + (cc >> 6), dim = (cc & 63) + 64 * half; col = sec * 1024 + head * 128 + dim; }
        else if (pn < 16) col = n0;
        else col = (half ? 5120 : 4096) + (pn - 16) * 128 + cc;
        return a.in[8] + col; }
    if (seg == 9) { ld = DM; return a.in[10] + n0; }
    { const int tile = n0 >> 8, within = n0 & 255, half = within >> 7, j = tile * 128 + (within & 127); ld = DM; return (half ? a.in[20] : a.in[19]) + j; }
}
__device__ __forceinline__ void transpose_item(const float* W, int ld, bf16_t* WT, int K, int n0, int k0, LAS float* scr, int lane) {
#pragma unroll 8
    for (int i = 0; i < 32; ++i) { const int kk = 2 * i + (lane >> 5); scr[kk * 33 + (lane & 31)] = W[(size_t)(k0 + kk) * ld + (lane & 31)]; }
    LDS_WAIT();
    const int c = lane & 7;
#pragma unroll
    for (int j = 0; j < 4; ++j) { const int n = (lane >> 3) + 8 * j; const LAS float* s = scr + (8 * c) * 33 + n;
        u32x4 o; o.x = cvtpk(s[0 * 33], s[1 * 33]); o.y = cvtpk(s[2 * 33], s[3 * 33]); o.z = cvtpk(s[4 * 33], s[5 * 33]); o.w = cvtpk(s[6 * 33], s[7 * 33]);
        *(u32x4*)(WT + (size_t)(n0 + n) * K + k0 + 8 * c) = o; }
    LDS_WAIT();
}
__device__ __forceinline__ void p0_weights(const Args& a, LAS unsigned char* lds, int gw, int NGW, int wave, int lane) {
    LAS float* scr = (LAS float*)(lds + wave * 8448);
    constexpr int I13 = (2 * FF / 32) * (DM / 64), I2 = (DM / 32) * (FF / 64), IIN = (6144 / 32) * (DM / 64), IOUT = (DM / 32) * (DM / 64), IAB = (4096 / 32) * (DM / 64);
    constexpr int TOTAL = 4 * I13 + 4 * I2 + IIN + IOUT + IAB;
    for (int it = gw; it < TOTAL; it += NGW) {
        int r = it, seg, rows, K; bf16_t* dst;
        if (r < 4 * I13) { seg = r / I13; r -= seg * I13; rows = 2 * FF; K = DM; dst = (bf16_t*)(a.ws + WS_W13 + (size_t)seg * W13_SZ); }
        else { r -= 4 * I13;
            if (r < 4 * I2) { const int i = r / I2; r -= i * I2; seg = 4 + i; rows = DM; K = FF; dst = (bf16_t*)(a.ws + WS_W2 + (size_t)i * W2_SZ); }
            else { r -= 4 * I2;
                if (r < IIN) { seg = 8; rows = 6144; K = DM; dst = (bf16_t*)(a.ws + WS_WIN); }
                else { r -= IIN;
                    if (r < IOUT) { seg = 9; rows = DM; K = DM; dst = (bf16_t*)(a.ws + WS_WOUT); }
                    else { r -= IOUT; seg = 10; rows = 4096; K = DM; dst = (bf16_t*)(a.ws + WS_WAB); } } } }
        const int nblk = rows / 32, nb = r % nblk, kb = r / nblk; int ld;
        const float* W = src_base(a, seg, nb * 32, ld);
        transpose_item(W, ld, dst, K, nb * 32, kb * 64, scr, lane);
    }
}
__device__ __forceinline__ void p0_tables(const Args& a, int gtid, int NT) {
    float* cs = (float*)(a.ws + WS_CS);
    for (int i = gtid; i < SEQ * 64; i += NT) { const int pos = i >> 6, j = i & 63;
        const float inv = (float)pow(10000.0, -(double)j / 64.0); const float ang = (float)pos * inv;
        cs[i] = (float)cos((double)ang); cs[SEQ * 64 + i] = (float)sin((double)ang); }
    float* A = (float*)(a.ws + WS_S5A); float* BT = (float*)(a.ws + WS_S5B); float* CT = (float*)(a.ws + WS_S5C);
    for (int i = gtid; i < 128 * 64; i += NT) { const int g = i >> 6, p = i & 63;
        const double lr = a.in[11][i], li = a.in[12][i], dt = exp((double)a.in[13][g]);
        const double mag = exp(lr * dt), ar = mag * cos(li * dt), ai = mag * sin(li * dt), den = lr * lr + li * li;
        const double fr = ((ar - 1.0) * lr + ai * li) / den, fi = (ai * lr - (ar - 1.0) * li) / den;
        A[2 * i] = (float)ar; A[2 * i + 1] = (float)ai;
        for (int c = 0; c < 16; ++c) { const double br = a.in[14][(size_t)i * 16 + c], bi = a.in[15][(size_t)i * 16 + c];
            BT[((size_t)g * 16 + c) * 128 + 2 * p] = (float)(fr * br - fi * bi); BT[((size_t)g * 16 + c) * 128 + 2 * p + 1] = (float)(fr * bi + fi * br);
            CT[((size_t)g * 128 + 2 * p) * 16 + c] = a.in[16][((size_t)g * 16 + c) * 64 + p]; CT[((size_t)g * 128 + 2 * p + 1) * 16 + c] = -a.in[17][((size_t)g * 16 + c) * 64 + p]; }
    }
}
__device__ __forceinline__ void first_rows(const float* src, float* cpy, const float* gamma, bf16_t* xn, float* ss0, int gw, int NGW, int lane) {
    for (int m = gw; m < M_; m += NGW) {
        const f32x4* xr = (const f32x4*)(src + (size_t)m * DM) + lane; f32x4 v[8]; float s = 0.f;
#pragma unroll
        for (int j = 0; j < 8; ++j) { v[j] = xr[64 * j]; s += (v[j].x * v[j].x + v[j].y * v[j].y) + (v[j].z * v[j].z + v[j].w * v[j].w); }
        s = wave_sum(s); if (lane == 0) ss0[m] = s;
        const f32x4* gr = (const f32x4*)gamma + lane; u32x2* o = (u32x2*)(xn + (size_t)m * DM) + lane;
#pragma unroll
        for (int j = 0; j < 8; ++j) { const f32x4 g = gr[64 * j]; u32x2 w; w.x = cvtpk(v[j].x * g.x, v[j].y * g.y); w.y = cvtpk(v[j].z * g.z, v[j].w * g.w); o[64 * j] = w; }
    }
}
__device__ __forceinline__ void final_norm(float* h, const float* gamma, int m_begin, int m_end, int step, int lane) {
    for (int m = m_begin; m < m_end; m += step) {
        f32x4* xr = (f32x4*)(h + (size_t)m * DM) + lane; f32x4 v[8]; float s = 0.f;
#pragma unroll
        for (int j = 0; j < 8; ++j) { v[j] = xr[64 * j]; s += (v[j].x * v[j].x + v[j].y * v[j].y) + (v[j].z * v[j].z + v[j].w * v[j].w); }
        const float rs = 1.0f / sqrtf(wave_sum(s) * (1.0f / DM) + RMS_EPS);
        const f32x4* gr = (const f32x4*)gamma + lane;
#pragma unroll
        for (int j = 0; j < 8; ++j) xr[64 * j] = v[j] * rs * gr[64 * j];
    }
}
#define MFMA32(a, b, c) __builtin_amdgcn_mfma_f32_32x32x16_bf16((a), (b), (c), 0, 0, 0)
typedef short v4i16_t __attribute__((ext_vector_type(4)));
__device__ __forceinline__ s16x4 vtr(unsigned byte_addr) { return __builtin_bit_cast(s16x4, __builtin_amdgcn_ds_read_tr16_b64_v4i16((LAS v4i16_t*)(size_t)byte_addr)); }
__device__ __forceinline__ void attn_task(const bf16_t* Q, const bf16_t* Kb, const bf16_t* Vb, bf16_t* OB, int ostride, float* LSE, LAS unsigned char* vl, int b, int hd, int lg, int r, int T, int lane) {
    const int qi = lane & 31, h = lane >> 5, lr = lane >> 4, lp = lane & 15;
    const int cq = 32 * T + qi;
    const size_t qrow = (size_t)b * SEQ + (cq << lg) + r;
    const int ckbase = 32 * T - 128;
    int c = ckbase < 0 ? (-ckbase) >> 5 : 0;
#define ATT_ROWPTR(P, ck, it) ((P) + ((size_t)b * SEQ + (((ck) + 4 * (it) + lr) << lg) + r) * 1024 + hd * 128 + 8 * lp)
    u32x4 kr[8], vr[8];
#pragma unroll
    for (int it = 0; it < 8; ++it) kr[it] = *(const u32x4*)ATT_ROWPTR(Q, 32 * T, it);
#pragma unroll
    for (int it = 0; it < 8; ++it) *(LAS u32x4*)(vl + (4 * it + lr) * 272 + 16 * lp) = kr[it];
#pragma unroll
    for (int it = 0; it < 8; ++it) kr[it] = *(const u32x4*)ATT_ROWPTR(Kb, ckbase + 32 * c, it);
#pragma unroll
    for (int it = 0; it < 8; ++it) vr[it] = *(const u32x4*)ATT_ROWPTR(Vb, ckbase + 32 * c, it);
    LDS_WAIT();
#pragma unroll
    for (int ks = 0; ks < 8; ++ks) *(LAS bf16x8*)(vl + 10240 + (ks * 64 + lane) * 16) = *(LAS bf16x8*)(vl + qi * 272 + 32 * ks + 16 * h);
    LDS_WAIT();
    f32x16 o[4];
#pragma unroll
    for (int dc = 0; dc < 4; ++dc)
#pragma unroll
        for (int i = 0; i < 16; ++i) o[dc][i] = 0.f;
    float m_run = -1e30f, l_run = 0.f;
    const int i16 = lane & 15, tq = i16 >> 2, tp = i16 & 3, blk = (lane >> 4) & 1;
    const unsigned vbase = (unsigned)(size_t)vl;
    const unsigned tr_off = vbase + (unsigned)((4 * h + tq) * 320 + 2 * (16 * blk + 4 * tp));
    for (;;) {
        const bool has_next = c < 4;
        const int ck0 = ckbase + 32 * c;
#pragma unroll
        for (int it = 0; it < 8; ++it) *(LAS u32x4*)(vl + (4 * it + lr) * 272 + 16 * lp) = kr[it];
        if (has_next) {
#pragma unroll
            for (int it = 0; it < 8; ++it) kr[it] = *(const u32x4*)ATT_ROWPTR(Kb, ck0 + 32, it); }
        LDS_WAIT();
        f32x16 s;
#pragma unroll
        for (int i = 0; i < 16; ++i) s[i] = 0.f;
#pragma unroll
        for (int ks = 0; ks < 8; ++ks) s = MFMA32(*(LAS bf16x8*)(vl + qi * 272 + 32 * ks + 16 * h), *(LAS bf16x8*)(vl + 10240 + (ks * 64 + lane) * 16), s);
        LDS_WAIT();
#pragma unroll
        for (int it = 0; it < 8; ++it) *(LAS u32x4*)(vl + (4 * it + lr) * 320 + 16 * lp) = vr[it];
        if (has_next) {
#pragma unroll
            for (int it = 0; it < 8; ++it) vr[it] = *(const u32x4*)ATT_ROWPTR(Vb, ck0 + 32, it); }
        float mx = -1e30f;
        if (c == 0 || c == 4) {
#pragma unroll
            for (int i = 0; i < 16; ++i) { const int ck = ck0 + (i & 3) + 8 * (i >> 2) + 4 * h; const bool ok = (ck <= cq) && (ck >= cq - 128); s[i] = ok ? s[i] : -1e30f; } }
#pragma unroll
        for (int i = 0; i < 16; ++i) mx = fmaxf(mx, s[i]);
        mx = fmaxf(mx, __shfl_xor(mx, 32));
        const float m_new = fmaxf(m_run, mx), alpha = __builtin_amdgcn_exp2f(m_run - m_new);
        float ps = 0.f;
#pragma unroll
        for (int i = 0; i < 16; ++i) { const float p = (s[i] > -1e29f) ? __builtin_amdgcn_exp2f(s[i] - m_new) : 0.f; s[i] = p; ps += p; }
        l_run = l_run * alpha + ps; m_run = m_new;
#pragma unroll
        for (int dc = 0; dc < 4; ++dc)
#pragma unroll
            for (int i = 0; i < 16; ++i) o[dc][i] *= alpha;
        bf16x8 pf[2];
#pragma unroll
        for (int s2 = 0; s2 < 2; ++s2) { u32x4 w; w.x = cvtpk(s[8 * s2 + 0], s[8 * s2 + 1]); w.y = cvtpk(s[8 * s2 + 2], s[8 * s2 + 3]); w.z = cvtpk(s[8 * s2 + 4], s[8 * s2 + 5]); w.w = cvtpk(s[8 * s2 + 6], s[8 * s2 + 7]); pf[s2] = __builtin_bit_cast(bf16x8, w); }
        LDS_WAIT();
#pragma unroll
        for (int dc = 0; dc < 4; ++dc)
#pragma unroll
            for (int s2 = 0; s2 < 2; ++s2) {
                const s16x4 lo = vtr(tr_off + (unsigned)(16 * s2 * 320 + 64 * dc)), hi = vtr(tr_off + (unsigned)((16 * s2 + 8) * 320 + 64 * dc));
                const bf16x8 va = __builtin_shufflevector(lo, hi, 0, 1, 2, 3, 4, 5, 6, 7);
                o[dc] = MFMA32(va, pf[s2], o[dc]); }
        LDS_WAIT();
        if (!has_next) break;
        ++c;
    }
#undef ATT_ROWPTR
    const float l = l_run + __shfl_xor(l_run, 32), inv = 1.0f / l;
    if (h == 0) LSE[qrow * 8 + hd] = m_run + __builtin_amdgcn_logf(l);
    bf16_t* op = OB + qrow * ostride + hd * 128 + 4 * h;
#pragma unroll
    for (int dc = 0; dc < 4; ++dc)
#pragma unroll
        for (int g = 0; g < 4; ++g) { u32x2 w; w.x = cvtpk(o[dc][4 * g] * inv, o[dc][4 * g + 1] * inv); w.y = cvtpk(o[dc][4 * g + 2] * inv, o[dc][4 * g + 3] * inv);
            *(u32x2*)(op + 32 * dc + 8 * g) = w; }
}
__device__ __forceinline__ void attn_mix_conv(const bf16_t* O0, const bf16_t* O1, const float* LSE, size_t lse_bs, const bf16_t* U, const bf16_t* GB, const float* cw, bf16_t* CAT, int row_begin, int nrows, int gtid, int NT) {
    for (int idx = gtid; idx < nrows * 128; idx += NT) { const int row = row_begin + (idx >> 7), c8 = (idx & 127) * 8, pos = row & (SEQ - 1), hd = c8 >> 7;
        { const float l0 = LSE[(size_t)row * 8 + hd], l1 = LSE[lse_bs + (size_t)row * 8 + hd], l2 = LSE[2 * lse_bs + (size_t)row * 8 + hd];
          const float mm = fmaxf(l0, fmaxf(l1, l2)); float w0 = __builtin_amdgcn_exp2f(l0 - mm), w1 = __builtin_amdgcn_exp2f(l1 - mm), w2 = __builtin_amdgcn_exp2f(l2 - mm);
          const float iw = 1.0f / (w0 + w1 + w2); w0 *= iw; w1 *= iw; w2 *= iw;
          const u32x4 a0 = *(const u32x4*)(O0 + (size_t)row * 1024 + c8), a1 = *(const u32x4*)(O1 + (size_t)row * 1024 + c8), a2 = *(const u32x4*)(CAT + (size_t)row * DM + c8);
          u32x4 ov;
#pragma unroll
          for (int j = 0; j < 4; ++j) ov[j] = cvtpk(w0 * bf_lo(a0[j]) + w1 * bf_lo(a1[j]) + w2 * bf_lo(a2[j]), w0 * bf_hi(a0[j]) + w1 * bf_hi(a1[j]) + w2 * bf_hi(a2[j]));
          *(u32x4*)(CAT + (size_t)row * DM + c8) = ov; }
        const u32x4 z = {0u, 0u, 0u, 0u};
        const u32x4 u0 = *(const u32x4*)(U + (size_t)row * 1024 + c8), u1 = pos >= 1 ? *(const u32x4*)(U + (size_t)(row - 1) * 1024 + c8) : z, u2 = pos >= 2 ? *(const u32x4*)(U + (size_t)(row - 2) * 1024 + c8) : z;
        const u32x4 gb = *(const u32x4*)(GB + (size_t)row * 1024 + c8);
        u32x4 ov;
#pragma unroll
        for (int j = 0; j < 4; ++j) { const int ch = c8 + 2 * j;
            const float a = bf_lo(gb[j]) * (cw[ch] * bf_lo(u2[j]) + cw[1024 + ch] * bf_lo(u1[j]) + cw[2048 + ch] * bf_lo(u0[j]));
            const float bq = bf_hi(gb[j]) * (cw[ch + 1] * bf_hi(u2[j]) + cw[1024 + ch + 1] * bf_hi(u1[j]) + cw[2048 + ch + 1] * bf_hi(u0[j]));
            ov[j] = cvtpk(a, bq); }
        *(u32x4*)(CAT + (size_t)row * DM + 1024 + c8) = ov; }
}
#define MFMA16(a, b, c) __builtin_amdgcn_mfma_f32_16x16x32_bf16((a), (b), (c), 0, 0, 0)
__device__ __forceinline__ void s5_task(const Args& a, const bf16_t* XN, const float* SS, bf16_t* Y, LAS float* S, int b, int g, int lane) {
    const float* A = (const float*)(a.ws + WS_S5A); const float* BT = (const float*)(a.ws + WS_S5B); const float* CT = (const float*)(a.ws + WS_S5C);
    const int n16 = lane & 15, j4 = lane >> 4;
    const float ar = A[(g * 64 + lane) * 2], ai = A[(g * 64 + lane) * 2 + 1];
    bf16x8 bw[8], cw[4];
#pragma unroll
    for (int ct = 0; ct < 8; ++ct) { unsigned w[4];
#pragma unroll
        for (int jj = 0; jj < 4; ++jj) { float v[2];
#pragma unroll
            for (int e = 0; e < 2; ++e) { const float x = BT[((size_t)g * 16 + 8 * (j4 & 1) + 2 * jj + e) * 128 + 8 * n16 + ct]; const float hi = __uint_as_float(cvtpk(x, 0.f) << 16); v[e] = (j4 < 2) ? x : (x - hi); }
            w[jj] = cvtpk(v[0], v[1]); }
        bw[ct] = __builtin_bit_cast(bf16x8, (u32x4){w[0], w[1], w[2], w[3]}); }
#pragma unroll
    for (int kk = 0; kk < 4; ++kk) { unsigned w[4];
#pragma unroll
        for (int jj = 0; jj < 4; ++jj) w[jj] = cvtpk(CT[((size_t)g * 128 + 32 * kk + 8 * j4 + 2 * jj) * 16 + n16], CT[((size_t)g * 128 + 32 * kk + 8 * j4 + 2 * jj + 1) * 16 + n16]);
        cw[kk] = __builtin_bit_cast(bf16x8, (u32x4){w[0], w[1], w[2], w[3]}); }
    bf16x8 dw;
    { unsigned w[4];
#pragma unroll
      for (int jj = 0; jj < 4; ++jj) { float v[2];
#pragma unroll
          for (int e = 0; e < 2; ++e) { const int c = 8 * (j4 & 1) + 2 * jj + e; const float x = (c == n16) ? a.in[18][g * 16 + n16] : 0.f; const float hi = __uint_as_float(cvtpk(x, 0.f) << 16); v[e] = (j4 < 2) ? x : (x - hi); }
          w[jj] = cvtpk(v[0], v[1]); }
      dw = __builtin_bit_cast(bf16x8, (u32x4){w[0], w[1], w[2], w[3]}); }
    float sre = 0.f, sim = 0.f;
    const size_t rowb = (size_t)b * SEQ;
    LAS unsigned short* YS = (LAS unsigned short*)(S + 16 * 132);
    u32x4 unext = *(const u32x4*)(XN + (rowb + n16) * DM + 16 * g + 8 * (j4 & 1));
    float ssn = SS[rowb + n16];
    for (int blk = 0; blk < SEQ / 16; ++blk) {
        const size_t row0 = rowb + blk * 16;
        const u32x4 uraw = unext; const float rsl = rs_of(ssn);
        { const size_t rn = (blk + 1 < SEQ / 16) ? row0 + 16 : row0;
          unext = *(const u32x4*)(XN + (rn + n16) * DM + 16 * g + 8 * (j4 & 1)); ssn = SS[rn + n16]; }
        float rsw[4];
#pragma unroll
        for (int i = 0; i < 4; ++i) rsw[i] = __shfl(rsl, 4 * j4 + i);
        const bf16x8 ua = __builtin_bit_cast(bf16x8, uraw);
        f32x4 bu[8];
#pragma unroll
        for (int ct = 0; ct < 8; ++ct) bu[ct] = MFMA16(ua, bw[ct], ((f32x4){0.f, 0.f, 0.f, 0.f}));
        const f32x4 yd = MFMA16(ua, dw, ((f32x4){0.f, 0.f, 0.f, 0.f}));
#pragma unroll
        for (int i = 0; i < 4; ++i) { LAS float* w = S + (4 * j4 + i) * 132 + 8 * n16; const float q = rsw[i];
            *(LAS f32x4*)w = (f32x4){bu[0][i] * q, bu[1][i] * q, bu[2][i] * q, bu[3][i] * q}; *(LAS f32x4*)(w + 4) = (f32x4){bu[4][i] * q, bu[5][i] * q, bu[6][i] * q, bu[7][i] * q}; }
        LDS_WAIT();
#pragma unroll
        for (int tt = 0; tt < 16; ++tt) { LAS f32x2* sp = (LAS f32x2*)(S + tt * 132 + 2 * lane); const f32x2 v = *sp;
            const float nre = ar * sre - ai * sim + v.x, nim = ar * sim + ai * sre + v.y; sre = nre; sim = nim; *sp = (f32x2){sre, sim}; }
        LDS_WAIT();
        f32x4 y = {0.f, 0.f, 0.f, 0.f};
#pragma unroll
        for (int kk = 0; kk < 4; ++kk) { const f32x4 s0 = *(LAS f32x4*)(S + n16 * 132 + 32 * kk + 8 * j4), s1 = *(LAS f32x4*)(S + n16 * 132 + 32 * kk + 8 * j4 + 4);
            const bf16x8 sa = __builtin_bit_cast(bf16x8, (u32x4){cvtpk(s0[0], s0[1]), cvtpk(s0[2], s0[3]), cvtpk(s1[0], s1[1]), cvtpk(s1[2], s1[3])});
            y = MFMA16(sa, cw[kk], y); }
#pragma unroll
        for (int i = 0; i < 4; ++i) { const float v = y[i] + yd[i] * rsw[i];
            const float ge = v * sigmoid_f(1.5957691216057308f * (v + 0.044715f * v * v * v));
            YS[(4 * j4 + i) * 16 + n16] = (unsigned short)(cvtpk(ge, 0.f) & 0xffffu); }
        LDS_WAIT();
        { const u32x2 o = *(LAS u32x2*)(YS + 4 * lane);
          *(u32x2*)(Y + (row0 + (lane >> 2)) * DM + 16 * g + 4 * (lane & 3)) = o; }
        LDS_WAIT();
    }
}

__device__ __forceinline__ void group_barrier(unsigned* ctr, unsigned nmem, unsigned& phase, bool samex) {
    asm volatile("s_waitcnt vmcnt(0)" ::: "memory");
    __syncthreads();
    ++phase;
    if (threadIdx.x == 0) {
        if (!samex) { __builtin_amdgcn_fence(__ATOMIC_RELEASE, "agent"); asm volatile("s_waitcnt vmcnt(0)" ::: "memory"); }
        __hip_atomic_fetch_add(ctr, 1u, __ATOMIC_RELAXED, __HIP_MEMORY_SCOPE_AGENT);
        const unsigned want = nmem * phase;
        while (__hip_atomic_load(ctr, __ATOMIC_RELAXED, __HIP_MEMORY_SCOPE_AGENT) < want) __builtin_amdgcn_s_sleep(2);
        __builtin_amdgcn_fence(__ATOMIC_ACQUIRE, "agent");
        asm volatile("s_waitcnt vmcnt(0)" ::: "memory");
    }
    __syncthreads();
}

#ifndef REP_UP
#define REP_UP 1
#endif
#ifndef REP_DN
#define REP_DN 1
#endif
#ifndef REP_P0
#define REP_P0 1
#endif
#ifndef REP_ATT
#define REP_ATT 1
#endif
#ifndef REP_S5
#define REP_S5 1
#endif
__global__ void __launch_bounds__(512, 2) mk_fwd(Args args) {
    extern __shared__ __attribute__((aligned(16))) unsigned char lds_raw[];
    cg::grid_group grid = cg::this_grid();
    LAS unsigned char* lds = (LAS unsigned char*)lds_raw;
    const int tid = threadIdx.x, lane = tid & 63, wave = __builtin_amdgcn_readfirstlane(tid >> 6);
    const int G = gridDim.x, gw = blockIdx.x * 8 + wave, NGW = G * 8, gtid = blockIdx.x * 512 + tid, NT = G * 512;
    const int NG = (G % 8 == 0) ? 8 : 1, grp = (NG == 8) ? (int)(blockIdx.x & 7) : 0, rk = (NG == 8) ? (int)(blockIdx.x >> 3) : (int)blockIdx.x, MEM = G / NG;
    const int gwv = rk * 8 + wave, NGWV = MEM * 8, gtv = rk * 512 + tid, NTV = MEM * 512;
    const int RPG = M_ / NG, row_g = grp * RPG;
    unsigned char* ws = args.ws; float* H = args.out;
    bf16_t* XN = (bf16_t*)(ws + WS_XN); bf16_t* BIG = (bf16_t*)(ws + WS_BIG); bf16_t* CAT = (bf16_t*)(ws + WS_CAT);
    unsigned char* slice = ws + WS_BIG + (size_t)grp * ((size_t)RPG * FF * 2); const size_t PSZ = (size_t)RPG * 1024 * 2;
    bf16_t* Qb = (bf16_t*)slice - (size_t)row_g * 1024; bf16_t* Kb = (bf16_t*)(slice + PSZ) - (size_t)row_g * 1024; bf16_t* Vb = (bf16_t*)(slice + 2 * PSZ) - (size_t)row_g * 1024;
    bf16_t* GBb = (bf16_t*)(slice + 3 * PSZ) - (size_t)row_g * 1024; bf16_t* Ub = (bf16_t*)(slice + 4 * PSZ) - (size_t)row_g * 1024;
    float* LSE = (float*)(slice + 5 * PSZ) - (size_t)row_g * 8; const size_t lse_bs = (size_t)RPG * 8;
    unsigned char* xslice = ws + WS_XN + (size_t)grp * ((size_t)RPG * DM * 2);
    bf16_t* O0 = (bf16_t*)xslice - (size_t)row_g * 1024; bf16_t* O1 = (bf16_t*)(xslice + PSZ) - (size_t)row_g * 1024;

    float* SS = (float*)(ws + WS_SS);
    unsigned* gwords = (unsigned*)(ws + WS_GRP); unsigned* gctr = gwords + 64 * grp; unsigned* gmask = gwords + 1024 + 64 * grp;
    unsigned bphase = 0; bool samex = false;
    if (blockIdx.x == 0 && tid < 16) gwords[(tid >> 3) * 1024 + 64 * (tid & 7)] = 0u;
    for (int i = gtid; i < 6 * M_; i += NT) SS[M_ + i] = 0.f;
    for (int i = gtid; i < 128 * 64; i += NT) ((unsigned*)(ws + WS_PCNT))[i] = 0u;
    for (int rep = 0; rep < REP_P0; ++rep) p0_weights(args, lds, gw, NGW, wave, lane);
    p0_tables(args, gtid, NT);
    first_rows(args.in[0], H, args.in[1], XN, SS, gw, NGW, lane);
    grid.sync();
    if (NG == 8 && tid == 0) __hip_atomic_fetch_or(gmask, 1u << ((unsigned)__builtin_amdgcn_s_getreg((3 << 11) | 20) & 0xFu), __ATOMIC_RELAXED, __HIP_MEMORY_SCOPE_AGENT);
#define PBAR() do { if (NG == 1) grid.sync(); else group_barrier(gctr, (unsigned)MEM, bphase, samex); } while (0)

#define FFN(l, f, ssi, NEXT, gam, sso, hin, FIRST) do { \
    { pg8::Gemm g{XN, (const bf16_t*)(ws + WS_W13 + (size_t)((l) * 2 + (f)) * W13_SZ), M_, 2 * FF, DM}; pg8::StaticOrder S; S.init(M_, 2 * FF, G, (int)blockIdx.x); \
      pg8::EpiSwiGLU E{BIG, FF, SS + (size_t)(ssi) * M_, (LAS float*)(lds + 131072), -1}; pg8::gemm_phase<pg8::EpiSwiGLU, pg8::StaticOrder, true, true>(lds, g, S, E); } \
    PBAR(); \
    if (FIRST) { if (NG == 8) { const unsigned mk = __hip_atomic_load(gmask, __ATOMIC_RELAXED, __HIP_MEMORY_SCOPE_AGENT); samex = (mk & (mk - 1u)) == 0u; } } \
    { pg8::Gemm g{BIG, (const bf16_t*)(ws + WS_W2 + (size_t)((l) * 2 + (f)) * W2_SZ), M_, DM, FF}; pg8::StaticOrder S; S.init(M_, DM, G, (int)blockIdx.x, 1, 4); \
      pg8::EpiResid<NEXT> E{(hin), H, DM, 0.5f, (gam), XN, SS + (size_t)(sso) * M_}; pg8::gemm_phase<pg8::EpiResid<NEXT>, pg8::StaticOrder, true, true>(lds, g, S, E); } \
    PBAR(); } while (0)

    FFN(0, 0, 0, true, args.in[2], 1, args.in[0], true);
    { pg8::Gemm g{XN, (const bf16_t*)(ws + WS_WIN), M_, 6144, DM}; pg8::StaticOrder S; S.init(M_, 6144, G, (int)blockIdx.x);
      pg8::EpiInProj E{Qb, Kb, Vb, GBb, Ub, (const float*)(ws + WS_CS), 0.08838834764831845f * 1.4426950408889634f, SS + (size_t)1 * M_};
      pg8::gemm_phase<pg8::EpiInProj, pg8::StaticOrder, true, true>(lds, g, S, E); }
    PBAR();
    { const int tpg = 24576 / NG;
      for (int tt = gwv; tt < tpg; tt += NGWV) { const int t = grp * tpg + tt; const int b = t / 1536, rem = t - b * 1536, hd = rem / 192, rem2 = rem - hd * 192, br = rem2 >> 6, idx = rem2 & 63;
          const int lg = br == 0 ? 4 : (br == 1 ? 2 : 0), tpc = 64 >> lg, r = idx / tpc, T = idx - r * tpc;
          bf16_t* OB = br == 0 ? O0 : (br == 1 ? O1 : CAT);
          attn_task(Qb, Kb, Vb, OB, br == 2 ? DM : 1024, LSE + (size_t)br * lse_bs, lds + wave * 18432, b, hd, lg, r, T, lane); }
      PBAR();
      attn_mix_conv(O0, O1, LSE, lse_bs, Ub, GBb, args.in[9], CAT, row_g, RPG, gtv, NTV); }
    PBAR();
    { pg8::Gemm g{CAT, (const bf16_t*)(ws + WS_WOUT), M_, DM, DM}; pg8::StaticOrder S; S.init(M_, DM, G, (int)blockIdx.x, 1, 4);
      pg8::EpiResid<true> E{H, H, DM, 1.0f, args.in[3], XN, SS + (size_t)2 * M_}; pg8::gemm_phase<pg8::EpiResid<true>, pg8::StaticOrder, true, true>(lds, g, S, E); }
    PBAR();
    FFN(0, 1, 2, true, args.in[1] + DM, 3, H, false);
    FFN(1, 0, 3, true, args.in[2] + DM, 4, H, false);
    { size_t z5 = 0; asm volatile("" : "+s"(z5));
      const bf16_t* xn5 = XN + z5; bf16_t* y5 = CAT + z5; const float* ss5 = SS + (size_t)4 * M_ + z5;
      const int lane5 = (int)__builtin_amdgcn_mbcnt_hi(~0u, __builtin_amdgcn_mbcnt_lo(~0u, 0u));
      const int wpg = 2048 / NG;
      for (int w = gwv; w < wpg; w += NGWV) { const int wt = grp * wpg + w; s5_task(args, xn5, ss5, y5, (LAS float*)(lds + wave * 9216), wt >> 7, wt & 127, lane5); } }
    PBAR();
    { pg8::Gemm g{CAT, (const bf16_t*)(ws + WS_WAB), M_, 4096, DM}; pg8::StaticOrder S; S.init(M_, 4096, G, (int)blockIdx.x, 1, 2);
      pg8::EpiGLU E{H, DM, args.in[3] + DM, XN, SS + (size_t)5 * M_}; pg8::gemm_phase<pg8::EpiGLU, pg8::StaticOrder, true, true>(lds, g, S, E); }
    PBAR();
    if (G == 256) {
        { pg8::Gemm g{XN, (const bf16_t*)(ws + WS_W13 + (size_t)3 * W13_SZ), M_, 2 * FF, DM}; pg8::StaticOrder S; S.init(M_, 2 * FF, G, (int)blockIdx.x);
          pg8::EpiSwiGLU E{BIG, FF, SS + (size_t)5 * M_, (LAS float*)(lds + 131072), -1}; pg8::gemm_phase<pg8::EpiSwiGLU, pg8::StaticOrder, true, true>(lds, g, S, E); }
        PBAR();
        { pg8::Gemm g{BIG, (const bf16_t*)(ws + WS_W2 + (size_t)3 * W2_SZ), M_, DM, FF}; pg8::StaticOrder S; S.init(M_, DM, G, (int)blockIdx.x, 1, 4);
          pg8::EpiFinal E{H, H, DM, 0.5f, args.in[4], SS + (size_t)6 * M_, (unsigned*)(ws + WS_PCNT)}; pg8::gemm_phase<pg8::EpiFinal, pg8::StaticOrder, true, true>(lds, g, S, E); }
    } else {
        FFN(1, 1, 5, false, args.in[4], 0, H, false);
        final_norm(H, args.in[4], row_g + gwv, row_g + RPG, NGWV, lane);
    }
}

extern "C" void kernel_launch(void* const* d_in, const int* in_sizes, int n_in, void* d_out, int out_size, void* d_ws, size_t ws_size, hipStream_t stream) {
    static int grid = 0;
    if (grid == 0) {
        if (n_in != 21 || out_size != M_ * DM || ws_size < WS_END) { fprintf(stderr, "kernel_launch: unexpected problem (n_in %d out %d ws %zu, need %zu)\n", n_in, out_size, ws_size, (size_t)WS_END); grid = -1; return; }
        int dev = 0, cus = 0, per_cu = 0;
        hipGetDevice(&dev); hipDeviceGetAttribute(&cus, hipDeviceAttributeMultiprocessorCount, dev);
        if (hipFuncSetAttribute((const void*)mk_fwd, hipFuncAttributeMaxDynamicSharedMemorySize, LDS_BYTES) != hipSuccess) { fprintf(stderr, "kernel_launch: hipFuncSetAttribute failed\n"); grid = -1; return; }
        if (hipOccupancyMaxActiveBlocksPerMultiprocessor(&per_cu, (const void*)mk_fwd, 512, LDS_BYTES) != hipSuccess || per_cu < 1) { fprintf(stderr, "kernel_launch: occupancy query says %d\n", per_cu); per_cu = 1; (void)hipGetLastError(); }
        grid = cus * per_cu;
    }
    if (grid < 0) return;
    Args a{};
    for (int i = 0; i < 21; ++i) a.in[i] = (const float*)d_in[i];
    a.out = (float*)d_out; a.ws = (unsigned char*)d_ws;
    void* kargs[] = {&a};
    hipError_t e = hipLaunchCooperativeKernel((const void*)mk_fwd, dim3(grid), dim3(512), kargs, LDS_BYTES, stream);
    if (e != hipSuccess) fprintf(stderr, "cooperative launch failed: %s (grid %d)\n", hipGetErrorString(e), grid);
}
```
